# Optimizing an MI355X kernel written in HIP

```python
import math
import jax, jax.numpy as jnp
from jax import lax
import numpy as np

D_MODEL = 2048
BATCH = 2
SEQ = 4096
DEPTH = 1

HEAD_DIM = 128
NSA_HEADS = 8
NSA_KV_HEADS = 2
NSA_GROUP = NSA_HEADS // NSA_KV_HEADS
CMP_BLOCK = 32
CMP_STRIDE = 16
CMP_HIDDEN = 256
SEL_BLOCK = 64
SEL_TOPN = 16
WINDOW = 512
FORCED_SCORE = 1e4
MOBA_HEADS = 8
MOBA_BLOCK = 256
MOBA_TOPK = 3
N_HEADS_TOTAL = NSA_HEADS + MOBA_HEADS
REL_BUCKETS = 32
REL_MAX_DIST = 128
N_GROUPS = 8
EXPERTS_PER_GROUP = 8
N_EXPERTS = N_GROUPS * EXPERTS_PER_GROUP
EXPERT_FF = D_MODEL // 4
EXPERT_TOPK = 2
MOE_ROW_BLOCK = 128
Q_CHUNK = 64
BAND_BLOCK = 128
RMS_EPS = 1e-6
NSA_Q_COLS = NSA_HEADS * HEAD_DIM
NSA_KV_COLS = NSA_KV_HEADS * HEAD_DIM
NSA_GATE_COLS = 3 * NSA_HEADS
MOBA_COLS = MOBA_HEADS * HEAD_DIM
IN_SPLITS = (NSA_Q_COLS,) + (NSA_KV_COLS,) * 6 + (NSA_GATE_COLS, MOBA_COLS, MOBA_COLS, MOBA_COLS, D_MODEL, D_MODEL)
IN_COLS = sum(IN_SPLITS)

kernel_name = 'hybrid_nsa_moba_hier_moe_block'


def rmsnorm(x, g):
    xf = x.astype(jnp.float32)
    y = xf * lax.rsqrt(jnp.mean(xf * xf, axis=-1, keepdims=True) + RMS_EPS)
    return (y * g.astype(jnp.float32)).astype(x.dtype)


def rel_bucket(dist):
    n = jnp.maximum(jnp.asarray(dist, jnp.int32), 0)
    max_exact = REL_BUCKETS // 2
    nf = jnp.maximum(n, 1).astype(jnp.float32)
    large = max_exact + (jnp.log(nf / max_exact) / math.log(REL_MAX_DIST / max_exact) * (REL_BUCKETS - max_exact)).astype(jnp.int32)
    return jnp.where(n < max_exact, n, jnp.minimum(large, REL_BUCKETS - 1))


def masked_softmax(logits, mask):
    logits = jnp.where(mask, logits, -jnp.inf)
    m = jnp.max(logits, axis=-1, keepdims=True)
    m = jnp.where(jnp.isfinite(m), m, 0.0)
    p = jnp.exp(logits - m)
    d = jnp.sum(p, axis=-1, keepdims=True)
    return p / jnp.where(d > 0, d, 1.0)


def compress_blocks(kv, pe, w1, w2):
    B, S, G, dh = kv.shape
    n_c = (S - CMP_BLOCK) // CMP_STRIDE + 1
    idx = np.arange(n_c)[:, None] * CMP_STRIDE + np.arange(CMP_BLOCK)[None, :]
    blocks = kv[:, idx] + pe[None, None, :, None, :]
    blocks = blocks.transpose(0, 3, 1, 2, 4).reshape(B, G, n_c, CMP_BLOCK * dh)
    return jax.nn.gelu(blocks @ w1) @ w2


def nsa_mixer(q, k_cmp, v_cmp, k_slc, v_slc, k_win, v_win, gate_logits,
              pe_k, w1_k, w2_k, pe_v, w1_v, w2_v, rel_tab):
    B, S, H, dh = q.shape
    G = k_cmp.shape[2]
    hg = H // G
    scale = dh ** -0.5
    t = np.arange(S)
    qg = q.reshape(B, S, G, hg, dh).transpose(0, 2, 3, 1, 4)

    kc = compress_blocks(k_cmp, pe_k, w1_k, w2_k)
    vc = compress_blocks(v_cmp, pe_v, w1_v, w2_v)
    n_c = kc.shape[2]
    c_start = np.arange(n_c) * CMP_STRIDE
    dist_c = t[:, None] - (c_start + CMP_BLOCK - 1)[None, :]
    bias_c = rel_tab[rel_bucket(dist_c)].transpose(2, 0, 1).reshape(G, hg, S, n_c)
    logit_c = jnp.einsum('bgjsd,bgcd->bgjsc', qg, kc).astype(jnp.float32) * scale + bias_c
    p_c = masked_softmax(logit_c, dist_c >= 0)
    o_c = jnp.einsum('bgjsc,bgcd->bgjsd', p_c.astype(vc.dtype), vc)

    n_sel = S // SEL_BLOCK
    sb_start = np.arange(n_sel) * SEL_BLOCK
    overlap = (c_start[None, :] < sb_start[:, None] + SEL_BLOCK) & (c_start[None, :] + CMP_BLOCK > sb_start[:, None])
    p_sel = jnp.einsum('bgjsc,nc->bgsn', p_c, jnp.asarray(overlap, jnp.float32))
    j = np.arange(n_sel)[None, :]
    cur = (t // SEL_BLOCK)[:, None]
    valid = sb_start[None, :] <= t[:, None]
    forced = (j == 0) | (j == cur) | (j == cur - 1)
    score = jnp.where(forced, FORCED_SCORE, jnp.where(valid, p_sel, -jnp.inf))
    n_top = min(SEL_TOPN, n_sel)
    _, sel_idx = lax.top_k(score, n_top)

    ks_b = k_slc.transpose(0, 2, 1, 3).reshape(B, G, n_sel, SEL_BLOCK, dh)
    vs_b = v_slc.transpose(0, 2, 1, 3).reshape(B, G, n_sel, SEL_BLOCK, dh)
    tab_g = rel_tab.reshape(REL_BUCKETS, G, hg).transpose(1, 0, 2)
    b_ix = jnp.arange(B)[:, None, None, None]
    g_ix = jnp.arange(G)[None, :, None, None]
    n_keys = n_top * SEL_BLOCK

    def sel_chunk(ci):
        t0 = ci * Q_CHUNK
        qc = lax.dynamic_slice_in_dim(qg, t0, Q_CHUNK, axis=3)
        ic = lax.dynamic_slice_in_dim(sel_idx, t0, Q_CHUNK, axis=2)
        kk = ks_b[b_ix, g_ix, ic].reshape(B, G, Q_CHUNK, n_keys, dh)
        vv = vs_b[b_ix, g_ix, ic].reshape(B, G, Q_CHUNK, n_keys, dh)
        pos = (ic[..., None] * SEL_BLOCK + jnp.arange(SEL_BLOCK)).reshape(B, G, Q_CHUNK, n_keys)
        dist = (t0 + jnp.arange(Q_CHUNK))[:, None] - pos
        bias = jnp.moveaxis(tab_g[g_ix, rel_bucket(dist)], -1, 2)
        logit = jnp.einsum('bgjqd,bgqld->bgjql', qc, kk).astype(jnp.float32) * scale + bias
        p = masked_softmax(logit, (dist >= 0)[:, :, None])
        return jnp.einsum('bgjql,bgqld->bgjqd', p.astype(vv.dtype), vv)

    o_s = lax.map(sel_chunk, jnp.arange(S // Q_CHUNK))
    o_s = jnp.moveaxis(o_s, 0, 3).reshape(B, G, hg, S, dh)

    n_band = S // BAND_BLOCK
    span = BAND_BLOCK + WINDOW
    band_idx = np.arange(n_band)[:, None] * BAND_BLOCK + np.arange(span)[None, :]
    pad = ((0, 0), (0, 0), (WINDOW, 0), (0, 0))
    kw_b = jnp.pad(k_win.transpose(0, 2, 1, 3), pad)[:, :, band_idx]
    vw_b = jnp.pad(v_win.transpose(0, 2, 1, 3), pad)[:, :, band_idx]
    qb = qg.reshape(B, G, hg, n_band, BAND_BLOCK, dh)
    r = np.arange(BAND_BLOCK)[:, None]
    c = np.arange(span)[None, :]
    dist_w = r + WINDOW - c
    key_pos = np.arange(n_band)[:, None, None] * BAND_BLOCK + c[None] - WINDOW
    mask_w = (dist_w >= 0) & (dist_w < WINDOW) & (key_pos >= 0)
    bias_w = rel_tab[rel_bucket(dist_w)].transpose(2, 0, 1).reshape(G, hg, 1, BAND_BLOCK, span)
    logit_w = jnp.einsum('bgjnqd,bgnkd->bgjnqk', qb, kw_b).astype(jnp.float32) * scale + bias_w
    p_w = masked_softmax(logit_w, mask_w)
    o_w = jnp.einsum('bgjnqk,bgnkd->bgjnqd', p_w.astype(vw_b.dtype), vw_b).reshape(B, G, hg, S, dh)

    gates = jax.nn.sigmoid(gate_logits.astype(jnp.float32)).reshape(B, S, H, 3)

    def to_bshd(o):
        return o.transpose(0, 3, 1, 2, 4).reshape(B, S, H, dh)

    out = gates[..., 0:1] * to_bshd(o_c) + gates[..., 1:2] * to_bshd(o_s) + gates[..., 2:3] * to_bshd(o_w)
    return out.reshape(B, S, H * dh).astype(q.dtype)


def moba_mixer(q, k, v, rel_tab):
    B, S, H, dh = q.shape
    scale = dh ** -0.5
    q, k, v = (a.transpose(0, 2, 1, 3) for a in (q, k, v))
    n_blk = -(-S // MOBA_BLOCK)
    pad = ((0, 0), (0, 0), (0, n_blk * MOBA_BLOCK - S), (0, 0))
    kb = jnp.pad(k, pad).reshape(B, H, n_blk, MOBA_BLOCK, dh)
    vb = jnp.pad(v, pad).reshape(B, H, n_blk, MOBA_BLOCK, dh)
    k_mean = jnp.mean(kb, axis=3)
    t = np.arange(S)
    own = t // MOBA_BLOCK
    past = np.arange(n_blk)[None, :] < own[:, None]
    gate = jnp.einsum('bhsd,bhnd->bhsn', q, k_mean).astype(jnp.float32)
    gate = jnp.where(past, gate, -jnp.inf)
    n_top = max(1, min(MOBA_TOPK, n_blk - 1))
    _, top_idx = lax.top_k(gate, n_top)
    top_ok = top_idx < own[:, None]
    tab_h = rel_tab.T
    b_ix = jnp.arange(B)[:, None, None, None]
    h_ix = jnp.arange(H)[None, :, None, None]
    n_keys = n_top * MOBA_BLOCK

    def chunk(ci):
        t0 = ci * Q_CHUNK
        blk = t0 // MOBA_BLOCK
        tq = t0 + jnp.arange(Q_CHUNK)
        qc = lax.dynamic_slice_in_dim(q, t0, Q_CHUNK, axis=2)
        ic = lax.dynamic_slice_in_dim(top_idx, t0, Q_CHUNK, axis=2)
        okc = lax.dynamic_slice_in_dim(top_ok, t0, Q_CHUNK, axis=2)
        kk = kb[b_ix, h_ix, ic].reshape(B, H, Q_CHUNK, n_keys, dh)
        vv = vb[b_ix, h_ix, ic].reshape(B, H, Q_CHUNK, n_keys, dh)
        pos = (ic[..., None] * MOBA_BLOCK + jnp.arange(MOBA_BLOCK)).reshape(B, H, Q_CHUNK, n_keys)
        mask_sel = jnp.repeat(okc, MOBA_BLOCK, axis=-1)
        bias_sel = tab_h[h_ix, rel_bucket(tq[:, None] - pos)]
        k_own = lax.dynamic_index_in_dim(kb, blk, axis=2, keepdims=False)
        v_own = lax.dynamic_index_in_dim(vb, blk, axis=2, keepdims=False)
        dist_own = tq[:, None] - (blk * MOBA_BLOCK + jnp.arange(MOBA_BLOCK))[None, :]
        bias_own = rel_tab[rel_bucket(dist_own)].transpose(2, 0, 1)
        l_sel = jnp.einsum('bhqd,bhqld->bhql', qc, kk).astype(jnp.float32) * scale + bias_sel
        l_own = jnp.einsum('bhqd,bhkd->bhqk', qc, k_own).astype(jnp.float32) * scale + bias_own
        logit = jnp.concatenate([l_sel, l_own], axis=-1)
        mask = jnp.concatenate([mask_sel, jnp.broadcast_to(dist_own >= 0, (B, H, Q_CHUNK, MOBA_BLOCK))], axis=-1)
        p = masked_softmax(logit, mask).astype(v.dtype)
        return (jnp.einsum('bhql,bhqld->bhqd', p[..., :n_keys], vv)
                + jnp.einsum('bhqk,bhkd->bhqd', p[..., n_keys:], v_own))

    o = lax.map(chunk, jnp.arange(S // Q_CHUNK))
    o = jnp.moveaxis(o, 0, 2).reshape(B, H, S, dh)
    return o.transpose(0, 2, 1, 3).reshape(B, S, H * dh)


def hier_moe(h, w_group, b_group, w_router, b_router, w_gate, w_up, w_down):
    B, S, D = h.shape
    T = B * S
    ht = h.reshape(T, D)
    g_prob = jax.nn.softmax((ht @ w_group).astype(jnp.float32) + b_group, axis=-1)
    g_val, g_idx = lax.top_k(g_prob, 1)
    e_logit = jnp.einsum('td,gde->tge', ht, w_router).astype(jnp.float32) + b_router
    e_logit = jnp.take_along_axis(e_logit, g_idx[:, :, None], axis=1)[:, 0]
    e_val, e_idx = lax.top_k(jax.nn.softmax(e_logit, axis=-1), EXPERT_TOPK)
    weights = g_val * e_val / jnp.sum(e_val, axis=-1, keepdims=True)
    expert = g_idx * EXPERTS_PER_GROUP + e_idx

    n_assign = T * EXPERT_TOPK
    flat_e = expert.reshape(-1)
    flat_tok = jnp.repeat(jnp.arange(T), EXPERT_TOPK)
    flat_w = weights.reshape(-1)
    order = jnp.argsort(flat_e)
    s_e, s_tok, s_w = flat_e[order], flat_tok[order], flat_w[order]
    counts = jnp.bincount(flat_e, length=N_EXPERTS)
    padded = (counts + MOE_ROW_BLOCK - 1) // MOE_ROW_BLOCK * MOE_ROW_BLOCK
    pad_end = jnp.cumsum(padded)
    pad_start = pad_end - padded
    start = jnp.cumsum(counts) - counts
    dest = pad_start[s_e] + jnp.arange(n_assign) - start[s_e]
    n_blocks = -(-(n_assign + N_EXPERTS * (MOE_ROW_BLOCK - 1)) // MOE_ROW_BLOCK)
    n_rows = n_blocks * MOE_ROW_BLOCK
    row_tok = jnp.zeros((n_rows,), jnp.int32).at[dest].set(s_tok)
    row_w = jnp.zeros((n_rows,), jnp.float32).at[dest].set(s_w)
    block_e = jnp.minimum(jnp.searchsorted(pad_end, jnp.arange(n_blocks) * MOE_ROW_BLOCK, side='right'), N_EXPERTS - 1)

    def run_block(args):
        tok, e = args
        xr = ht[tok]
        return (jax.nn.silu(xr @ w_gate[e]) * (xr @ w_up[e])) @ w_down[e]

    y = lax.map(run_block, (row_tok.reshape(n_blocks, MOE_ROW_BLOCK), block_e)).reshape(n_rows, D)
    y = (y.astype(jnp.float32) * row_w[:, None]).astype(h.dtype)
    out = jnp.zeros((T, D), h.dtype).at[row_tok].add(y)
    return out.reshape(B, S, D)


def setup_inputs(seed: int = 0) -> dict:
    key = jax.random.key(seed)
    ks = jax.random.split(key, 24)

    def nrm(k, shape, scale):
        return jax.random.normal(k, shape, jnp.float32) * scale

    dh = HEAD_DIM
    return {
        'x': nrm(ks[0], (BATCH, SEQ, D_MODEL), 1.0),
        'rel_bias': nrm(ks[1], (REL_BUCKETS, N_HEADS_TOTAL), 0.2),
        'norm_mix': 1.0 + nrm(ks[2], (DEPTH, D_MODEL), 0.01),
        'w_in': nrm(ks[3], (DEPTH, D_MODEL, IN_COLS), D_MODEL ** -0.5),
        'cmp_pe_k': nrm(ks[4], (DEPTH, CMP_BLOCK, dh), 0.1),
        'cmp_w1_k': nrm(ks[5], (DEPTH, CMP_BLOCK * dh, CMP_HIDDEN), (CMP_BLOCK * dh) ** -0.5),
        'cmp_w2_k': nrm(ks[6], (DEPTH, CMP_HIDDEN, dh), CMP_HIDDEN ** -0.5),
        'cmp_pe_v': nrm(ks[7], (DEPTH, CMP_BLOCK, dh), 0.1),
        'cmp_w1_v': nrm(ks[8], (DEPTH, CMP_BLOCK * dh, CMP_HIDDEN), (CMP_BLOCK * dh) ** -0.5),
        'cmp_w2_v': nrm(ks[9], (DEPTH, CMP_HIDDEN, dh), CMP_HIDDEN ** -0.5),
        'w_up_nsa': nrm(ks[10], (DEPTH, NSA_Q_COLS, D_MODEL), NSA_Q_COLS ** -0.5),
        'w_up_moba': nrm(ks[11], (DEPTH, MOBA_COLS, D_MODEL), MOBA_COLS ** -0.5),
        'w_out': nrm(ks[12], (DEPTH, D_MODEL, D_MODEL), D_MODEL ** -0.5),
        'norm_ffn': 1.0 + nrm(ks[13], (DEPTH, D_MODEL), 0.01),
        'w_group': nrm(ks[14], (DEPTH, D_MODEL, N_GROUPS), D_MODEL ** -0.5),
        'b_group': nrm(ks[15], (DEPTH, N_GROUPS), 0.01),
        'w_router': nrm(ks[16], (DEPTH, N_GROUPS, D_MODEL, EXPERTS_PER_GROUP), D_MODEL ** -0.5),
        'b_router': nrm(ks[17], (DEPTH, N_GROUPS, EXPERTS_PER_GROUP), 0.01),
        'w_exp_gate': nrm(ks[18], (DEPTH, N_EXPERTS, D_MODEL, EXPERT_FF), D_MODEL ** -0.5),
        'w_exp_up': nrm(ks[19], (DEPTH, N_EXPERTS, D_MODEL, EXPERT_FF), D_MODEL ** -0.5),
        'w_exp_down': nrm(ks[20], (DEPTH, N_EXPERTS, EXPERT_FF, D_MODEL), EXPERT_FF ** -0.5),
        'final_norm': 1.0 + nrm(ks[21], (D_MODEL,), 0.01),
    }


def reference(x, rel_bias, norm_mix, w_in, cmp_pe_k, cmp_w1_k, cmp_w2_k, cmp_pe_v, cmp_w1_v, cmp_w2_v,
              w_up_nsa, w_up_moba, w_out, norm_ffn, w_group, b_group, w_router, b_router,
              w_exp_gate, w_exp_up, w_exp_down, final_norm):
    B, S, _ = x.shape
    split_at = [int(v) for v in np.cumsum(IN_SPLITS)[:-1]]
    tab_a = rel_bias[:, :NSA_HEADS]
    tab_b = rel_bias[:, NSA_HEADS:]

    def heads(a, n):
        return a.reshape(B, S, n, HEAD_DIM)

    for l in range(DEPTH):
        h = rmsnorm(x, norm_mix[l])
        (q_a, kc, vc, ksl, vsl, kw, vw, gate_a,
         q_b, k_b, v_b, gm_a, gm_b) = jnp.split(h @ w_in[l], split_at, axis=-1)
        o_a = nsa_mixer(heads(q_a, NSA_HEADS), heads(kc, NSA_KV_HEADS), heads(vc, NSA_KV_HEADS),
                        heads(ksl, NSA_KV_HEADS), heads(vsl, NSA_KV_HEADS),
                        heads(kw, NSA_KV_HEADS), heads(vw, NSA_KV_HEADS), gate_a,
                        cmp_pe_k[l], cmp_w1_k[l], cmp_w2_k[l], cmp_pe_v[l], cmp_w1_v[l], cmp_w2_v[l], tab_a)
        o_b = moba_mixer(heads(q_b, MOBA_HEADS), heads(k_b, MOBA_HEADS), heads(v_b, MOBA_HEADS), tab_b)
        merged = jax.nn.sigmoid(gm_a) * (o_a @ w_up_nsa[l]) + jax.nn.sigmoid(gm_b) * (o_b @ w_up_moba[l])
        x = x + merged @ w_out[l]
        x = x + hier_moe(rmsnorm(x, norm_ffn[l]), w_group[l], b_group[l], w_router[l], b_router[l],
                         w_exp_gate[l], w_exp_up[l], w_exp_down[l])
    return rmsnorm(x, final_norm)
```

```cpp
#include <hip/hip_runtime.h>
#include <cstdio>
#include <cstdint>
template <int X> __device__ __forceinline__ float quad_xor(float v) {
    constexpr int ctrl = X == 1 ? 0xB1 : X == 2 ? 0x4E : 0x1B;
    const int i = __builtin_bit_cast(int, v);
    return __builtin_bit_cast(float, __builtin_amdgcn_update_dpp(i, i, ctrl, 0xF, 0xF, true));
}
namespace pg8 {
#define PG8_LAS __attribute__((address_space(3)))
typedef unsigned short bf16_t;
typedef short bf16x8 __attribute__((ext_vector_type(8)));
typedef float f32x4 __attribute__((ext_vector_type(4)));
typedef unsigned u32x4 __attribute__((ext_vector_type(4)));
constexpr int BM = 256, BK = 64, HALF = 128, HTB = HALF * BK * 2  , STAGE_BYTES = 8 * HTB, NXCD = 8, WGM = 8;

__host__ __device__ __forceinline__ int lds_byte(int r, int c) { const int st = (r >> 4) * 2 + (c >> 5), rr = r & 15, cc = c & 31, ob = rr * 64 + cc * 2; return st * 1024 + (ob ^ (((ob >> 9) & 1) << 5)); }
__host__ __device__ __forceinline__ void stage_rc(int b, int& R, int& C) { const int st = b / 1024, sb = b % 1024, swz = sb ^ (((sb >> 9) & 1) << 5); R = (st >> 1) * 16 + swz / 64; C = (st & 1) * 32 + (swz % 64) / 2; }
__host__ __device__ __forceinline__ int perm32(int rho) { const int n = rho >> 4, i = rho & 15; return 8 * (i >> 2) + 4 * n + (i & 3); }

struct Unit { int pm, pn; const char* A; const char* B; int x0, x1, x2; };

struct StaticOrder {
    int nM, nN, nwg, G, c; const char* A; const char* Bt; size_t tstep;
    __device__ void init(const void* A_, const void* Bt_, int M, int N, int K, int G_, int c_) { nM = M / BM; nN = N / BM; nwg = nM * nN; G = G_; c = c_; A = (const char*)A_; Bt = (const char*)Bt_; tstep = (size_t)BM * K * 2; }
    __device__ bool next(int i, Unit& u) const {
        const long L = (long)i * G + c; if (c < 0 || L >= nwg) return false;
        int wgid = (int)L; { const int q = nwg / NXCD, r = nwg % NXCD, xcd = wgid % NXCD, off = wgid / NXCD; wgid = (xcd < r ? xcd * (q + 1) : r * (q + 1) + (xcd - r) * q) + off; }
        const int nig = WGM * nN, gid = wgid / nig, fm = gid * WGM, gsz = (nM - fm) < WGM ? (nM - fm) : WGM;
        u.pm = fm + ((wgid % nig) % gsz); u.pn = (wgid % nig) / gsz; u.A = A + (size_t)u.pm * tstep; u.B = Bt + (size_t)u.pn * tstep; u.x0 = u.x1 = u.x2 = 0; return true;
    }
    __device__ __forceinline__ void a_ready(const Unit&) const {}
    __device__ __forceinline__ void done(const Unit&) const {}
    __device__ __forceinline__ void gather(const Unit&, unsigned (&)[2][2], int) const {}
};

typedef float f32x2_cv __attribute__((ext_vector_type(2))); typedef __bf16 bf16x2_cv __attribute__((ext_vector_type(2)));
__device__ __forceinline__ unsigned cvt_pk_bf16(float lo, float hi) { f32x2_cv v = {lo, hi}; bf16x2_cv b = __builtin_convertvector(v, bf16x2_cv); return __builtin_bit_cast(unsigned, b); }

template <class Epi, class Sched, bool ALIGN_EPI, bool GATHER, bool FP8 = false, int SCA = 127>
__device__ __forceinline__ void gemm_phase(PG8_LAS unsigned char* lds, const int K, const Sched& S, const Epi& E, const int LD = 0) {
    int tid = threadIdx.x; asm volatile("" : "+v"(tid));
    const int wid = __builtin_amdgcn_readfirstlane(tid >> 6), lane = tid & 63, wr = wid >> 2, wc = wid & 3, fr = lane & 15, fq = lane >> 4;
    const int nt = K / BK, ld = LD ? LD : K;
    unsigned voC[2][2], voN[2][2], voffB[2];
    const size_t kstep = (size_t)(BK * 2);
    const size_t hstep = (size_t)HALF * ld * 2;
#pragma unroll
    for (int i = 0; i < 2; ++i) { int R, C; stage_rc(tid * 16 + i * 8192, R, C); const int Rb = Epi::PERM ? ((R & ~31) + perm32(R & 31)) : R;
        voC[0][i] = (unsigned)(R * ld + C) * 2u; voC[1][i] = voC[0][i] + (unsigned)hstep; voffB[i] = (unsigned)(Rb * ld + C) * 2u; }
    const unsigned ldsw = (unsigned)wid * 1024u;
    const int aoff = lds_byte(wr * 64 + fr, fq * 8), boff = lds_byte(wc * 32 + fr, fq * 8);
#define PG8_SA(b, h) (((b) * 2 + (h)) * HTB)
#define PG8_SB(b, h) ((4 + (b) * 2 + (h)) * HTB)
#define PG8_STAGE(bufoff, gbase, voff) do { _Pragma("unroll") for (int _i = 0; _i < 2; ++_i) \
        __builtin_amdgcn_global_load_lds((const unsigned*)((const char*)(gbase) + (voff)[_i]), (PG8_LAS unsigned*)(lds + (bufoff) + ldsw + _i * 8192), 16, 0, 0); } while (0)
    typedef int v8i_ __attribute__((ext_vector_type(8))); typedef int v4i_ __attribute__((ext_vector_type(4)));
#define PG8_LDA(dst, b, h) do { _Pragma("unroll") for (int m = 0; m < 4; ++m) { const v4i_ lo_ = *(const PG8_LAS v4i_*)(lds + PG8_SA(b, h) + aoff + m * 2048), hi_ = *(const PG8_LAS v4i_*)(lds + PG8_SA(b, h) + aoff + m * 2048 + 1024); \
        dst[m] = __builtin_shufflevector(lo_, hi_, 0, 1, 2, 3, 4, 5, 6, 7); } } while (0)
#define PG8_LDB(dst, b, h) do { _Pragma("unroll") for (int n = 0; n < 2; ++n) { const v4i_ lo_ = *(const PG8_LAS v4i_*)(lds + PG8_SB(b, h) + boff + n * 2048), hi_ = *(const PG8_LAS v4i_*)(lds + PG8_SB(b, h) + boff + n * 2048 + 1024); \
        dst[n] = __builtin_shufflevector(lo_, hi_, 0, 1, 2, 3, 4, 5, 6, 7); } } while (0)
#define PG8_MMA(ai, bj, At, Bt) do { __builtin_amdgcn_s_setprio(1); _Pragma("unroll") for (int m = 0; m < 4; ++m) _Pragma("unroll") for (int n = 0; n < 2; ++n) { \
        if constexpr (FP8) { acc[ai][bj][m][n] = __builtin_amdgcn_mfma_scale_f32_16x16x128_f8f6f4(Bt[n], At[m], acc[ai][bj][m][n], 0, 0, 0, 121, 0, SCA); } \
        else { acc[ai][bj][m][n] = __builtin_amdgcn_mfma_f32_16x16x32_bf16(__builtin_bit_cast(bf16x8, __builtin_shufflevector(Bt[n], Bt[n], 0, 1, 2, 3)), __builtin_bit_cast(bf16x8, __builtin_shufflevector(At[m], At[m], 0, 1, 2, 3)), acc[ai][bj][m][n], 0, 0, 0); \
               acc[ai][bj][m][n] = __builtin_amdgcn_mfma_f32_16x16x32_bf16(__builtin_bit_cast(bf16x8, __builtin_shufflevector(Bt[n], Bt[n], 4, 5, 6, 7)), __builtin_bit_cast(bf16x8, __builtin_shufflevector(At[m], At[m], 4, 5, 6, 7)), acc[ai][bj][m][n], 0, 0, 0); } } \
        __builtin_amdgcn_s_setprio(0); } while (0)
#define PG8_WAIT_V(n) asm volatile("s_waitcnt vmcnt(" #n ")" ::: "memory")
#define PG8_WAIT_L(n) asm volatile("s_waitcnt lgkmcnt(" #n ")" ::: "memory")
#define PG8_BAR __builtin_amdgcn_s_barrier()
#define PG8_SCHED __builtin_amdgcn_sched_barrier(0)
    Unit cur, nxt; int ui = 0;
    if (!S.next(0, cur)) return;
    f32x4 acc[2][2][4][2];
#pragma unroll
    for (int a = 0; a < 2; ++a)
#pragma unroll
        for (int b = 0; b < 2; ++b)
#pragma unroll
            for (int m = 0; m < 4; ++m)
#pragma unroll
                for (int n = 0; n < 2; ++n) acc[a][b][m][n] = (f32x4){0.f, 0.f, 0.f, 0.f};
    v8i_ At[4], B0[2], B1[2];
    const char* cA = cur.A; const char* cB = cur.B;
    S.a_ready(cur);
    if constexpr (GATHER) { S.gather(cur, voC, tid); }
#pragma unroll
    for (int h = 0; h < 2; ++h)
#pragma unroll
        for (int i = 0; i < 2; ++i) voN[h][i] = voC[h][i];
    PG8_STAGE(PG8_SB(0, 0), cB, voffB); PG8_STAGE(PG8_SB(0, 1), cB + hstep, voffB); PG8_STAGE(PG8_SA(0, 0), cA, voC[0]); PG8_STAGE(PG8_SA(0, 1), cA, voC[1]);
    if (wr == 1) PG8_BAR;
    PG8_WAIT_V(2); PG8_BAR;
    PG8_STAGE(PG8_SB(1, 0), cB + kstep, voffB); PG8_STAGE(PG8_SA(1, 0), cA + kstep, voC[0]); PG8_STAGE(PG8_SB(1, 1), cB + hstep + kstep, voffB);
    PG8_WAIT_V(6); PG8_BAR;
    for (;;) {
        const bool has_next = S.next(ui + 1, nxt);
        const char* nA = has_next ? nxt.A : cA; const char* nB = has_next ? nxt.B : cB;
        for (int t = 0; t < nt; t += 2) {
            const bool last = (t == nt - 2);
            const char* a1 = cA + (size_t)(t + 1) * kstep;
            const char* a2 = last ? nA : cA + (size_t)(t + 2) * kstep; const char* b2 = last ? nB : cB + (size_t)(t + 2) * kstep;
            const char* a3 = a2 + kstep; const char* b3 = b2 + kstep;
            if constexpr (FP8) { asm volatile("" : "+s"(a1), "+s"(a2), "+s"(a3), "+s"(b2), "+s"(b3)); }
            if (last && has_next) { S.a_ready(nxt); if constexpr (GATHER) { S.gather(nxt, voN, tid); } }
            unsigned v2[2][2];
#pragma unroll
            for (int h = 0; h < 2; ++h)
#pragma unroll
                for (int i = 0; i < 2; ++i) v2[h][i] = (GATHER && last) ? voN[h][i] : voC[h][i];
            if constexpr (FP8) {
#define PG8_LDA2(dst, b, h, m0) do { _Pragma("unroll") for (int m = 0; m < 2; ++m) { const v4i_ lo_ = *(const PG8_LAS v4i_*)(lds + PG8_SA(b, h) + aoff + ((m0) + m) * 2048), hi_ = *(const PG8_LAS v4i_*)(lds + PG8_SA(b, h) + aoff + ((m0) + m) * 2048 + 1024); \
        dst[m] = __builtin_shufflevector(lo_, hi_, 0, 1, 2, 3, 4, 5, 6, 7); } } while (0)
#define PG8_MMA2(ai, bj, At, Bt, m0) do { _Pragma("unroll") for (int m = 0; m < 2; ++m) _Pragma("unroll") for (int n = 0; n < 2; ++n) \
        acc[ai][bj][(m0) + m][n] = __builtin_amdgcn_mfma_scale_f32_16x16x128_f8f6f4(Bt[n], At[m], acc[ai][bj][(m0) + m][n], 0, 0, 0, 121, 0, SCA); } while (0)
#define PG8_SUPER(ai, b, h) do { __builtin_amdgcn_s_setprio(1); PG8_MMA2(ai, 0, At, B0, 0); PG8_MMA2(ai, 1, At, B1, 0); PG8_LDA2(At, b, h, 2); PG8_MMA2(ai, 0, At, B0, 2); PG8_MMA2(ai, 1, At, B1, 2); __builtin_amdgcn_s_setprio(0); } while (0)
            PG8_LDB(B0, 0, 0); PG8_LDB(B1, 0, 1); PG8_SCHED; PG8_LDA2(At, 0, 0, 0); PG8_STAGE(PG8_SA(1, 1), a1, voC[1]);
            PG8_WAIT_V(8); PG8_WAIT_L(0); PG8_BAR; PG8_SUPER(0, 0, 0); PG8_BAR; PG8_SCHED;
            PG8_LDA2(At, 0, 1, 0); PG8_STAGE(PG8_SB(0, 0), b2, voffB); PG8_STAGE(PG8_SB(0, 1), b2 + hstep, voffB); PG8_STAGE(PG8_SA(0, 0), a2, v2[0]);
            PG8_WAIT_V(8); PG8_WAIT_L(0); PG8_BAR; PG8_SUPER(1, 0, 1); PG8_BAR; PG8_SCHED;
            PG8_LDB(B0, 1, 0); PG8_LDB(B1, 1, 1); PG8_SCHED; PG8_LDA2(At, 1, 0, 0); PG8_STAGE(PG8_SA(0, 1), a2, v2[1]);
            PG8_WAIT_V(8); PG8_WAIT_L(0); PG8_BAR; PG8_SUPER(0, 1, 0); PG8_BAR; PG8_SCHED;
            PG8_LDA2(At, 1, 1, 0); PG8_STAGE(PG8_SB(1, 0), b3, voffB); PG8_STAGE(PG8_SB(1, 1), b3 + hstep, voffB); PG8_STAGE(PG8_SA(1, 0), a3, v2[0]);
            PG8_WAIT_V(8); PG8_WAIT_L(0); PG8_BAR; PG8_SUPER(1, 1, 1); PG8_BAR; PG8_SCHED;
#undef PG8_SUPER
#undef PG8_MMA2
#undef PG8_LDA2
            } else {
            PG8_LDB(B0, 0, 0); PG8_LDB(B1, 0, 1); PG8_SCHED; PG8_LDA(At, 0, 0); PG8_STAGE(PG8_SA(1, 1), a1, voC[1]);
            PG8_WAIT_V(8); PG8_WAIT_L(0); PG8_BAR; PG8_MMA(0, 0, At, B0); PG8_MMA(0, 1, At, B1); PG8_BAR; PG8_SCHED;
            PG8_LDA(At, 0, 1); PG8_STAGE(PG8_SB(0, 0), b2, voffB); PG8_STAGE(PG8_SB(0, 1), b2 + hstep, voffB); PG8_STAGE(PG8_SA(0, 0), a2, v2[0]);
            PG8_WAIT_V(8); PG8_WAIT_L(0); PG8_BAR; PG8_MMA(1, 0, At, B0); PG8_MMA(1, 1, At, B1); PG8_BAR; PG8_SCHED;
            PG8_LDB(B0, 1, 0); PG8_LDB(B1, 1, 1); PG8_SCHED; PG8_LDA(At, 1, 0); PG8_STAGE(PG8_SA(0, 1), a2, v2[1]);
            PG8_WAIT_V(8); PG8_WAIT_L(0); PG8_BAR; PG8_MMA(0, 0, At, B0); PG8_MMA(0, 1, At, B1); PG8_BAR; PG8_SCHED;
            PG8_LDA(At, 1, 1); PG8_STAGE(PG8_SB(1, 0), b3, voffB); PG8_STAGE(PG8_SB(1, 1), b3 + hstep, voffB); PG8_STAGE(PG8_SA(1, 0), a3, v2[0]);
            PG8_WAIT_V(8); PG8_WAIT_L(0); PG8_BAR; PG8_MMA(1, 0, At, B0); PG8_MMA(1, 1, At, B1); PG8_BAR; PG8_SCHED;
            }
        }
        if constexpr (ALIGN_EPI) { if (wr == 0) PG8_BAR; }
        E(acc, cur, wr, wc, fr, fq); S.done(cur);
        if (!has_next) break;
#pragma unroll
        for (int a = 0; a < 2; ++a)
#pragma unroll
            for (int b = 0; b < 2; ++b)
#pragma unroll
                for (int m = 0; m < 4; ++m)
#pragma unroll
                    for (int n = 0; n < 2; ++n) acc[a][b][m][n] = (f32x4){0.f, 0.f, 0.f, 0.f};
        cur = nxt; cA = nA; cB = nB; ++ui;
        if constexpr (GATHER) {
#pragma unroll
            for (int h = 0; h < 2; ++h)
#pragma unroll
                for (int i = 0; i < 2; ++i) voC[h][i] = voN[h][i];
        }
        if constexpr (ALIGN_EPI) { if (wr == 1) PG8_BAR; }
    }
    PG8_WAIT_V(0);
    if constexpr (!ALIGN_EPI) { if (wr == 0) PG8_BAR; }
    PG8_BAR;
#undef PG8_SA
#undef PG8_SB
#undef PG8_STAGE
#undef PG8_LDA
#undef PG8_LDB
#undef PG8_MMA
#undef PG8_WAIT_V
#undef PG8_WAIT_L
#undef PG8_BAR
#undef PG8_SCHED
}
}
namespace pg8 {
__device__ __forceinline__ float sigmoidf_fast(float x) { return __builtin_amdgcn_rcpf(1.0f + __builtin_amdgcn_exp2f(-1.4426950408889634f * x)); }
__device__ __forceinline__ float bf_lo(unsigned w) { return __uint_as_float(w << 16); }
__device__ __forceinline__ float bf_hi(unsigned w) { return __uint_as_float(w & 0xffff0000u); }

struct EpiProj {
    static constexpr bool PERM = true;
    bf16_t* QA; bf16_t* KV6; bf16_t* QKVB; bf16_t* GM; float* GATE;
    __device__ __forceinline__ void operator()(const f32x4 (&acc)[2][2][4][2], const Unit& u, int wr, int wc, int fr, int fq) const {
        const int row0 = u.pm * BM + wr * 64 + fr, pn = u.pn;
        if (pn < 22) {
            bf16_t* base; int nh, hd0;
            if (pn < 4) { base = QA; nh = 8; hd0 = 2 * pn; }
            else if (pn < 10) { base = KV6 + (size_t)(pn - 4) * 2097152u; nh = 2; hd0 = 0; }
            else { base = QKVB + (size_t)((pn - 10) >> 2) * 8388608u; nh = 8; hd0 = 2 * ((pn - 10) & 3); }
#pragma unroll
            for (int ai = 0; ai < 2; ++ai)
#pragma unroll
                for (int m = 0; m < 4; ++m) { const int row = row0 + ai * HALF + m * 16, b = row >> 12, t = row & 4095;
#pragma unroll
                    for (int bj = 0; bj < 2; ++bj) { const f32x4 v0 = acc[ai][bj][m][0], v1 = acc[ai][bj][m][1];
                        u32x4 w; w.x = cvt_pk_bf16(v0[0], v0[1]); w.y = cvt_pk_bf16(v0[2], v0[3]); w.z = cvt_pk_bf16(v1[0], v1[1]); w.w = cvt_pk_bf16(v1[2], v1[3]);
                        *(u32x4*)(base + ((size_t)((b * nh + hd0 + bj) * 4096 + t) * 128 + wc * 32 + 8 * fq)) = w; } }
        } else if (pn < 38) {
            int fq_ = fq, fr_ = fr; asm volatile("" : "+v"(fq_), "+v"(fr_)); const int row0 = u.pm * BM + wr * 64 + fr_;
            bf16_t* base = GM + (size_t)((pn - 22) >> 3) * 16777216u; const int col0 = ((pn - 22) & 7) * 256 + wc * 32 + 8 * fq_;
#pragma unroll
            for (int ai = 0; ai < 2; ++ai)
#pragma unroll
                for (int m = 0; m < 4; ++m) { bf16_t* rowp = base + (size_t)(row0 + ai * HALF + m * 16) * 2048 + col0;
#pragma unroll
                    for (int bj = 0; bj < 2; ++bj) { f32x4 v0 = acc[ai][bj][m][0], v1 = acc[ai][bj][m][1];
#pragma unroll
                        for (int j = 0; j < 4; ++j) { v0[j] = sigmoidf_fast(v0[j]); v1[j] = sigmoidf_fast(v1[j]); }
                        u32x4 w; w.x = cvt_pk_bf16(v0[0], v0[1]); w.y = cvt_pk_bf16(v0[2], v0[3]); w.z = cvt_pk_bf16(v1[0], v1[1]); w.w = cvt_pk_bf16(v1[2], v1[3]);
                        *(u32x4*)(rowp + bj * HALF) = w; } }
        } else {
            if (wc == 0) {
                int fq_ = fq, fr_ = fr; asm volatile("" : "+v"(fq_), "+v"(fr_));
                const int row0g = u.pm * BM + wr * 64 + fr_;
#pragma unroll
                for (int ai = 0; ai < 2; ++ai)
#pragma unroll
                    for (int m = 0; m < 4; ++m) { float* rowp = GATE + (size_t)(row0g + ai * HALF + m * 16) * 32 + 8 * fq_;
                        f32x4 v0 = acc[ai][0][m][0], v1 = acc[ai][0][m][1];
#pragma unroll
                        for (int j = 0; j < 4; ++j) { v0[j] = sigmoidf_fast(v0[j]); v1[j] = sigmoidf_fast(v1[j]); }
                        *(f32x4*)rowp = v0; *(f32x4*)(rowp + 4) = v1; }
            }
        }
    }
};

struct EpiF32 {
    static constexpr bool PERM = false;
    float* C; int ldc; const float* resid; float* SS;
    __device__ __forceinline__ void operator()(const f32x4 (&acc)[2][2][4][2], const Unit& u, int wr, int wc, int fr, int fq) const {
        const int row0 = u.pm * BM + wr * 64 + fr, col0 = u.pn * BM + wc * 32 + 4 * fq;
        f32x4 rv[2][4];
#define EF_LOAD(slot, g_) do { const size_t off_ = (size_t)(row0 + ((g_) >> 2) * HALF + ((g_) & 3) * 16) * ldc + col0; \
        _Pragma("unroll") for (int q = 0; q < 4; ++q) rv[slot][q] = resid ? *(const f32x4*)(resid + off_ + (q >> 1) * HALF + (q & 1) * 16) : (f32x4){0.f, 0.f, 0.f, 0.f}; } while (0)
        EF_LOAD(0, 0);
#pragma unroll
        for (int g = 0; g < 8; ++g) { const int ai = g >> 2, m = g & 3; const size_t off = (size_t)(row0 + ai * HALF + m * 16) * ldc + col0;
            if (g + 1 < 8) EF_LOAD((g + 1) & 1, g + 1);
            float ss = 0.f;
#pragma unroll
            for (int q = 0; q < 4; ++q) { const int bj = q >> 1, n = q & 1; const f32x4 v = acc[ai][bj][m][n] + rv[g & 1][q]; *(f32x4*)(C + off + bj * HALF + n * 16) = v;
                ss += (v[0] * v[0] + v[1] * v[1]) + (v[2] * v[2] + v[3] * v[3]); }
            if (SS) { ss += __shfl_xor(ss, 16); ss += __shfl_xor(ss, 32); if (fq == 0) SS[(size_t)(4 * u.pn + wc) * 8192 + row0 + ai * HALF + m * 16] = ss; } }
#undef EF_LOAD
    }
};

struct SplitKOrder {
    const char* A0; const char* B0k; const char* B0v; int c;
    __device__ bool next(int i, Unit& u) const {
        if (i != 0 || c < 0 || c >= 128) return false;
        const int ks = c & 7, pn = (c >> 3) & 1, pm = (c >> 4) & 3, kv = c >> 6;
        u.pm = pm; u.pn = pn; u.x0 = (kv * 8 + ks) * 1024 * 512; u.x1 = u.x2 = 0;
        u.A = A0 + ((size_t)kv * 2097152u + (size_t)pm * 256 * 2048 + ks * 256) * 2; u.B = (kv ? B0v : B0k) + ((size_t)pn * 256 * 2048 + ks * 256) * 2; return true;
    }
    __device__ __forceinline__ void a_ready(const Unit&) const {}
    __device__ __forceinline__ void done(const Unit&) const {}
    __device__ __forceinline__ void gather(const Unit&, unsigned (&)[2][2], int) const {}
};
struct EpiF32Split {
    static constexpr bool PERM = false;
    float* C;
    __device__ __forceinline__ void operator()(const f32x4 (&acc)[2][2][4][2], const Unit& u, int wr, int wc, int fr, int fq) const {
        const int row0 = u.pm * BM + wr * 64 + fr, col0 = u.pn * BM + wc * 32 + 4 * fq;
#pragma unroll
        for (int ai = 0; ai < 2; ++ai)
#pragma unroll
            for (int m = 0; m < 4; ++m) { float* rp = C + (size_t)u.x0 + (size_t)(row0 + ai * HALF + m * 16) * 512 + col0;
#pragma unroll
                for (int bj = 0; bj < 2; ++bj)
#pragma unroll
                    for (int n = 0; n < 2; ++n) *(f32x4*)(rp + bj * HALF + n * 16) = acc[ai][bj][m][n]; }
    }
};

template <bool ADD, bool PIPE = true> struct EpiGated {
    static constexpr bool PERM = true;
    bf16_t* O; const bf16_t* G; unsigned char* O8;
    __device__ __forceinline__ void operator()(const f32x4 (&acc)[2][2][4][2], const Unit& u, int wr, int wc, int fr, int fq) const {
        int fq_ = fq, fr_ = fr; if (!PIPE) asm volatile("" : "+v"(fq_), "+v"(fr_));
        const int row0 = u.pm * BM + wr * 64 + fr_, col0 = u.pn * BM + wc * 32 + 8 * fq_;
        u32x4 gv[2][2], ov[2][2];
#define EG_LOAD(slot, g_) do { const size_t off_ = (size_t)(row0 + ((g_) >> 2) * HALF + ((g_) & 3) * 16) * 2048 + col0; \
        _Pragma("unroll") for (int bj = 0; bj < 2; ++bj) { gv[slot][bj] = *(const u32x4*)(G + off_ + bj * HALF); if (ADD) ov[slot][bj] = *(const u32x4*)(O + off_ + bj * HALF); } } while (0)
        if (PIPE) EG_LOAD(0, 0);
#pragma unroll
        for (int gi = 0; gi < 8; ++gi) { const int ai = gi >> 2, m = gi & 3; const size_t off = (size_t)(row0 + ai * HALF + m * 16) * 2048 + col0;
            if (PIPE) { if (gi + 1 < 8) EG_LOAD((gi + 1) & 1, gi + 1); } else EG_LOAD(gi & 1, gi);
#pragma unroll
            for (int bj = 0; bj < 2; ++bj) { const u32x4 g = gv[gi & 1][bj]; f32x4 v0 = acc[ai][bj][m][0], v1 = acc[ai][bj][m][1];
                v0[0] *= bf_lo(g.x); v0[1] *= bf_hi(g.x); v0[2] *= bf_lo(g.y); v0[3] *= bf_hi(g.y); v1[0] *= bf_lo(g.z); v1[1] *= bf_hi(g.z); v1[2] *= bf_lo(g.w); v1[3] *= bf_hi(g.w);
                if (ADD) { const u32x4 o = ov[gi & 1][bj];
                    v0[0] += bf_lo(o.x); v0[1] += bf_hi(o.x); v0[2] += bf_lo(o.y); v0[3] += bf_hi(o.y); v1[0] += bf_lo(o.z); v1[1] += bf_hi(o.z); v1[2] += bf_lo(o.w); v1[3] += bf_hi(o.w); }
                if (ADD && O8) { int q0 = __builtin_amdgcn_cvt_pk_fp8_f32(v0[0], v0[1], 0, false); q0 = __builtin_amdgcn_cvt_pk_fp8_f32(v0[2], v0[3], q0, true); int q1 = __builtin_amdgcn_cvt_pk_fp8_f32(v1[0], v1[1], 0, false); q1 = __builtin_amdgcn_cvt_pk_fp8_f32(v1[2], v1[3], q1, true);
                    typedef unsigned u32x2_ __attribute__((ext_vector_type(2))); u32x2_ q; q.x = (unsigned)q0; q.y = (unsigned)q1; *(u32x2_*)(O8 + off + bj * HALF) = q; }
                else { u32x4 w; w.x = cvt_pk_bf16(v0[0], v0[1]); w.y = cvt_pk_bf16(v0[2], v0[3]); w.z = cvt_pk_bf16(v1[0], v1[1]); w.w = cvt_pk_bf16(v1[2], v1[3]);
                    *(u32x4*)(O + off + bj * HALF) = w; } } }
#undef EG_LOAD
    }
};

struct MoeTile { int e, mt, cnt, rowbase; };
}
namespace mg {
#define MLAS __attribute__((address_space(3)))
typedef short bf16x8 __attribute__((ext_vector_type(8)));
typedef short s16x4 __attribute__((ext_vector_type(4)));
typedef float f32x16 __attribute__((ext_vector_type(16)));
typedef float f32x4 __attribute__((ext_vector_type(4)));
typedef unsigned u32x4 __attribute__((ext_vector_type(4)));
typedef unsigned u32x2 __attribute__((ext_vector_type(2)));
typedef short v4i16_t __attribute__((ext_vector_type(4)));
constexpr int TM = 384, LA = 0, A_BYTES = TM * 128, LB = 2 * A_BYTES, B_BYTES = 16384, LT = LB + 2 * B_BYTES;
__device__ __forceinline__ unsigned off_b(unsigned row, unsigned ch) { return 256u * row + 16u * (ch ^ (((row & 3u) << 2) | ((row >> 2) & 3u))); }
__device__ __forceinline__ unsigned tr_read_addr(unsigned lane, unsigned c, unsigned t) {
    const unsigned h = lane >> 5, blk = (lane >> 4) & 1, q = (lane & 15) >> 2, p = lane & 3;
    return off_b(8 * h + 4 * t + q, 4 * c + 2 * blk + (p >> 1)) + 8 * (p & 1);
}
__device__ __forceinline__ s16x4 vtr(const MLAS char* p) { return __builtin_bit_cast(s16x4, __builtin_amdgcn_ds_read_tr16_b64_v4i16((MLAS v4i16_t*)p)); }
__device__ __forceinline__ unsigned cvt2(float lo, float hi) { typedef float f2 __attribute__((ext_vector_type(2))); typedef __bf16 b2 __attribute__((ext_vector_type(2))); f2 v = {lo, hi}; b2 b = __builtin_convertvector(v, b2); return __builtin_bit_cast(unsigned, b); }

struct MoeJob { int e, mt, cnt, rowbase, ns; };
struct MoeTileL { int e, mt, cnt, rowbase; };
struct MoePhase {
    const MLAS MoeTileL* tiles; int ntiles;
    const char* Abase;
    const float* W0; const float* W1;
    const int* bucket; const float* bucket_w;
    unsigned short* H; unsigned short* Y;
};

template <int MODE>
__device__ __forceinline__ void moe_phase(MLAS unsigned char* lds, const MoePhase& P, int c, int G) {
    constexpr int K = MODE == 0 ? 2048 : 512, NT = K / 64, LDN = MODE == 0 ? 512 : 2048, AROW = K * 2, NSL = MODE == 0 ? 8 : 16;
    int tid = threadIdx.x; asm volatile("" : "+v"(tid));
    const int wave = __builtin_amdgcn_readfirstlane(tid >> 6), lane = tid & 63, r32 = lane & 31, hi = lane >> 5, wm = wave & 3, wn = wave >> 2;
    MLAS char* Al = (MLAS char*)lds + LA; MLAS char* Bl = (MLAS char*)lds + LB;
    const int total = P.ntiles * NSL;
    int L = c; if (L >= total) return;
    const int ach = tid & 7, c4 = tid & 31, kr = tid >> 5;
    unsigned arow[3]; unsigned avalid = 0u;
    const float* bp = nullptr;
    const unsigned awr0 = (unsigned)(tid >> 3) * 128u + (((unsigned)ach ^ ((unsigned)(tid >> 4) & 7u)) << 4);
    const unsigned aoff0 = (unsigned)(wm * 96 + r32) * 128u + ((((unsigned)hi) ^ (((unsigned)(wm * 96 + r32) >> 1) & 7u)) << 4);
    const unsigned boff00 = tr_read_addr((unsigned)lane, (unsigned)wn, 0u);
#define MG_AOFF(s) (aoff0 ^ ((unsigned)(s) << 5))
#define MG_BOFF(j, t) ((boff00 ^ (128u * (j)) ^ (16u * (t))) + 1024u * (t))
    u32x4 sa0[6] = {}, sb0[4] = {}, sa1[6] = {}, sb1[4] = {};
    MoeJob J; int ui = 0;
    MLAS int* tabE = (MLAS int*)(lds + LT); MLAS float* tabW = (MLAS float*)(lds + LT + 4096);
#define MG_JOB(Lx) do { const int ti_ = (Lx) / NSL; J.e = P.tiles[ti_].e; J.mt = P.tiles[ti_].mt; J.cnt = P.tiles[ti_].cnt; J.rowbase = P.tiles[ti_].rowbase; J.ns = (Lx) % NSL; } while (0)
#define MG_SETUP() do { int tid_s = threadIdx.x; asm volatile("" : "+v"(tid_s)); avalid = 0u;     unsigned ent_[6] = {0u, 0u, 0u, 0u, 0u, 0u}; \
        if (MODE == 0) { _Pragma("unroll") for (int i = 0; i < 6; ++i) { const int idx = J.mt * TM + (tid_s >> 3) + 64 * i; ent_[i] = (unsigned)P.bucket[J.e * 8192 + (idx < J.cnt ? idx : 0)]; } \
            asm volatile("" : "+v"(ent_[0]), "+v"(ent_[1]), "+v"(ent_[2]), "+v"(ent_[3]), "+v"(ent_[4]), "+v"(ent_[5])); }     \
        _Pragma("unroll") for (int i = 0; i < 6; ++i) { const int idx = J.mt * TM + (tid_s >> 3) + 64 * i; unsigned rowoff = 0u; \
            if (idx < J.cnt) { avalid |= 1u << i; if (MODE == 0) rowoff = (ent_[i] & 0xffffu); else rowoff = (unsigned)(J.rowbase + idx); } \
            if (i & 1) arow[i >> 1] |= rowoff << 16; else arow[i >> 1] = rowoff; } \
        int kr_ = tid_s >> 5; const int c4_ = tid_s & 31;     \
        if (MODE == 0) bp = (c4_ < 16 ? P.W0 : P.W1) + (size_t)J.e * 2048 * 512 + J.ns * 64 + (c4_ & 15) * 4 + (size_t)kr_ * LDN; \
        else { bp = P.W0 + (size_t)J.e * 512 * 2048 + J.ns * 128 + c4_ * 4 + (size_t)kr_ * LDN; \
               if (tid_s < TM) { const int idx_ = J.mt * TM + tid_s; int ent_ = -1; float w_ = 0.f; if (idx_ < J.cnt) { ent_ = P.bucket[J.e * 8192 + idx_]; w_ = P.bucket_w[J.e * 8192 + idx_]; } \
                   tabE[(ui & 1) * TM + tid_s] = ent_; tabW[(ui & 1) * TM + tid_s] = w_; } } ++ui; } while (0)
#define MG_LOAD(SA, SB, t_) do { _Pragma("unroll") for (int i = 0; i < 6; ++i) if (avalid & (1u << i)) SA[i] = *(const u32x4*)(P.Abase + (size_t)(((arow[i >> 1] >> (16 * (i & 1))) & 0xffffu) * (unsigned)AROW + (unsigned)ach * 16u) + (size_t)(t_) * 128); \
          \
          \
        { const float* p_ = bp + (size_t)(64 * (t_)) * LDN; asm volatile("" : "+v"(p_)); _Pragma("unroll") for (int i = 0; i < 4; ++i) SB[i] = __builtin_nontemporal_load((const __attribute__((address_space(1))) u32x4*)(p_ + (size_t)(16 * i) * LDN)); } } while (0)
#define MG_WRITE(SA, SB, buf) do { _Pragma("unroll") for (int i = 0; i < 4; ++i) { const unsigned k = (unsigned)(kr + 16 * i); \
            u32x2 w; w.x = cvt2(__uint_as_float(SB[i].x), __uint_as_float(SB[i].y)); w.y = cvt2(__uint_as_float(SB[i].z), __uint_as_float(SB[i].w)); \
            *(MLAS u32x2*)(Bl + (buf) * B_BYTES + off_b(k, (unsigned)(c4 >> 1)) + (unsigned)(c4 & 1) * 8u) = w; } \
        _Pragma("unroll") for (int i = 0; i < 6; ++i) *(MLAS u32x4*)(Al + (buf) * A_BYTES + awr0 + i * 8192) = SA[i]; } while (0)
    MG_JOB(L); MG_SETUP(); MG_LOAD(sa0, sb0, 0); MG_LOAD(sa1, sb1, 1);
    for (;;) {
        f32x16 acc[3][2];
#pragma unroll
        for (int a = 0; a < 3; ++a)
#pragma unroll
            for (int b = 0; b < 2; ++b) acc[a][b] = f32x16{};
        MG_WRITE(sa0, sb0, 0); MG_LOAD(sa0, sb0, 2);
        __syncthreads();
#define MG_ITER(t_, SA, SB, WR_, LD_) do { const int t = (t_); const int cur = t & 1; \
        { const MLAS char* Ac = Al + cur * A_BYTES; const MLAS char* Bc = Bl + cur * B_BYTES; \
          _Pragma("unroll") for (int s = 0; s < 4; ++s) { \
            const bf16x8 a0 = *(const MLAS bf16x8*)(Ac + MG_AOFF(s)), a1 = *(const MLAS bf16x8*)(Ac + MG_AOFF(s) + 32 * 128), a2 = *(const MLAS bf16x8*)(Ac + MG_AOFF(s) + 64 * 128); \
            const s16x4 l0 = vtr(Bc + MG_BOFF(0, 0) + s * 4096), h0 = vtr(Bc + MG_BOFF(0, 1) + s * 4096), l1 = vtr(Bc + MG_BOFF(1, 0) + s * 4096), h1 = vtr(Bc + MG_BOFF(1, 1) + s * 4096); \
            const bf16x8 b0 = {l0[0], l0[1], l0[2], l0[3], h0[0], h0[1], h0[2], h0[3]}, b1 = {l1[0], l1[1], l1[2], l1[3], h1[0], h1[1], h1[2], h1[3]}; \
            acc[0][0] = __builtin_amdgcn_mfma_f32_32x32x16_bf16(a0, b0, acc[0][0], 0, 0, 0); acc[0][1] = __builtin_amdgcn_mfma_f32_32x32x16_bf16(a0, b1, acc[0][1], 0, 0, 0); \
            acc[1][0] = __builtin_amdgcn_mfma_f32_32x32x16_bf16(a1, b0, acc[1][0], 0, 0, 0); acc[1][1] = __builtin_amdgcn_mfma_f32_32x32x16_bf16(a1, b1, acc[1][1], 0, 0, 0); \
            acc[2][0] = __builtin_amdgcn_mfma_f32_32x32x16_bf16(a2, b0, acc[2][0], 0, 0, 0); acc[2][1] = __builtin_amdgcn_mfma_f32_32x32x16_bf16(a2, b1, acc[2][1], 0, 0, 0); __builtin_amdgcn_sched_barrier(0); } } \
        if (WR_) { MG_WRITE(SA, SB, cur ^ 1); if (LD_) MG_LOAD(SA, SB, t + 3); } \
        __syncthreads(); } while (0)
        for (int t2 = 0; t2 < NT - 4; t2 += 2) {
            MG_ITER(t2, sa1, sb1, true, true);
            MG_ITER(t2 + 1, sa0, sb0, true, true);
        }
        MG_ITER(NT - 4, sa1, sb1, true, true);
        MG_ITER(NT - 3, sa0, sb0, true, false);
        MG_ITER(NT - 2, sa1, sb1, true, false);
        MG_ITER(NT - 1, sa0, sb0, false, false);
        const MoeJob Jc = J; const int par = (ui - 1) & 1; (void)par;
        const int Ln = L + G; const bool more = Ln < total;
        if (more) { MG_JOB(Ln); MG_SETUP(); MG_LOAD(sa0, sb0, 0); MG_LOAD(sa1, sb1, 1); }
        int ln = lane; asm volatile("" : "+v"(ln));
        const int r32e = ln & 31, hie = ln >> 5;
        if (MODE == 0) {
            MLAS char* S1 = Al + wave * 6144 + hie * 256 + r32e * 2;
#pragma unroll
            for (int mt = 0; mt < 3; ++mt)
#pragma unroll
                for (int r = 0; r < 16; ++r) { const float g = acc[mt][0][r], u = acc[mt][1][r];
                    const float v = g * __builtin_amdgcn_rcpf(1.0f + __builtin_amdgcn_exp2f(-1.4426950408889634f * g)) * u; const float vn = quad_xor<1>(v);
                    if ((r32e & 1) == 0) *(MLAS unsigned*)(S1 + (mt * 32 + (r & 3) + 8 * (r >> 2)) * 64) = cvt2(v, vn); }
            __builtin_amdgcn_sched_barrier(0);
            const MLAS char* S2 = Al + wave * 6144 + (ln >> 2) * 64 + (ln & 3) * 16; const int idx0 = Jc.mt * TM + wm * 96 + (ln >> 2);
            unsigned short* hp = P.H + (size_t)(Jc.rowbase + idx0) * 512 + Jc.ns * 64 + wn * 32 + (ln & 3) * 8;
#pragma unroll
            for (int k = 0; k < 6; ++k) { if (k == 3) __builtin_amdgcn_sched_barrier(0);
                const u32x4 w = *(const MLAS u32x4*)(S2 + k * 1024);
                if (idx0 + 16 * k < Jc.cnt) *(u32x4*)(hp + (size_t)(16 * k) * 512) = w; }
        } else {
            MLAS char* S1 = Al + wave * 12288 + hie * 512 + r32e * 2;
            const MLAS float* tw = tabW + par * TM + wm * 96 + 4 * hie;
#pragma unroll
            for (int mt = 0; mt < 3; ++mt) { float wg[16];
#pragma unroll
                for (int r = 0; r < 16; ++r) wg[r] = tw[mt * 32 + (r & 3) + 8 * (r >> 2)];
                __builtin_amdgcn_sched_barrier(0);
#pragma unroll
                for (int r = 0; r < 16; ++r) { const int rowc = mt * 32 + (r & 3) + 8 * (r >> 2);
#pragma unroll
                    for (int j = 0; j < 2; ++j) { const float v = acc[mt][j][r] * wg[r]; const float vn = quad_xor<1>(v);
                        if ((r32e & 1) == 0) *(MLAS unsigned*)(S1 + rowc * 128 + j * 64) = cvt2(v, vn); } } }
            __builtin_amdgcn_sched_barrier(0);
            const MLAS char* S2 = Al + wave * 12288 + (ln >> 3) * 128 + (ln & 7) * 16; const MLAS int* te = tabE + par * TM + wm * 96 + (ln >> 3);
            const int coff = Jc.ns * 128 + (wn + 2 * ((ln & 7) >> 2)) * 32 + (ln & 3) * 8;
#pragma unroll
            for (int k = 0; k < 12; ++k) { if ((k & 3) == 0 && k) __builtin_amdgcn_sched_barrier(0);
                const int ent = te[8 * k]; const u32x4 w = *(const MLAS u32x4*)(S2 + k * 1024);
                if (ent >= 0) *(u32x4*)(P.Y + ((size_t)((ent >> 16) * 8192 + (ent & 0xffff)) * 2048 + coff)) = w; }
        }
        if (more) __syncthreads();
        if (!more) break;
        L = Ln;
    }
#undef MG_AOFF
#undef MG_BOFF
#undef MG_ITER
#undef MG_JOB
#undef MG_SETUP
#undef MG_LOAD
#undef MG_WRITE
    __syncthreads();
}
}
namespace att {
#define ALAS __attribute__((address_space(3)))
typedef unsigned short bf16;
typedef short bf16x8 __attribute__((ext_vector_type(8)));
typedef short s16x4 __attribute__((ext_vector_type(4)));
typedef float f32x16 __attribute__((ext_vector_type(16)));
typedef float f32x4 __attribute__((ext_vector_type(4)));
typedef unsigned u32x4 __attribute__((ext_vector_type(4)));
constexpr int SHM_V = 16384, SHM_K = 16384;
constexpr int A_V = 0, A_K = 32768, A_U = 0  , A_WS = 98304  , A_BT = A_WS + 2048  , A_MISC = A_BT + 2048;
constexpr float NEG_INF = -__builtin_inff();
constexpr float THR = 8.f;
enum { M_CMP = 0, M_SEL = 1, M_WIN = 2, M_MOBA = 3 };

#define KSWZ(row, colB) ((row) * 256 + ((colB) ^ (((row) & 15) << 4)))
#define SBAR() __builtin_amdgcn_sched_barrier(0)
__device__ __forceinline__ int v_st(int k, int c) { const int kk = (k & ~0xC) | ((k & 4) << 1) | ((k & 8) >> 1); return ((kk >> 3) * 4 + (c >> 5)) * 512 + ((kk & 7) * 32 + (c & 31)) * 2; }
__device__ __forceinline__ int v_rd_base(int lane) { return ((lane & 3) << 3) | (((lane >> 2) & 3) << 6) | (((lane >> 4) & 1) << 5) | (((lane >> 5) & 1) << 8); }
constexpr int v_rd_off(int d0, int ks, int half) { return d0 * 512 + ks * 4096 + half * 2048; }
__device__ __forceinline__ int crow(int r, int hi) { return (r & 3) + 8 * (r >> 2) + 4 * hi; }
typedef float f32x2_cv __attribute__((ext_vector_type(2))); typedef __bf16 bf16x2_cv __attribute__((ext_vector_type(2)));
__device__ __forceinline__ unsigned cvtpk(float lo, float hi) { f32x2_cv v = {lo, hi}; bf16x2_cv b = __builtin_convertvector(v, bf16x2_cv); return __builtin_bit_cast(unsigned, b); }

template <bool ONLY32>
__device__ __forceinline__ void qkt(f32x16& p0, f32x16& p1, const ALAS char* kbuf, int r32, int hi, const bf16x8 (&qr)[8]) {
    p0 = f32x16{}; p1 = f32x16{};
    if (ONLY32) {
#pragma unroll
        for (int d0 = 0; d0 < 8; ++d0) { const bf16x8 b0 = *reinterpret_cast<const ALAS bf16x8*>(kbuf + KSWZ(r32, (d0 * 16 + hi * 8) * 2));
            p0 = __builtin_amdgcn_mfma_f32_32x32x16_bf16(b0, qr[d0], p0, 0, 0, 0); }
    } else {
        unsigned ka[8];
#pragma unroll
        for (int dd = 0; dd < 8; ++dd) ka[dd] = (unsigned)(size_t)kbuf + (unsigned)KSWZ(r32, (dd * 16 + hi * 8) * 2);
        bf16x8 kb0, kb1, kb2, kb3;
#define KRD(dst, f) asm volatile("ds_read_b128 %0, %1 offset:%2" : "=&v"(dst) : "v"(ka[(f) >> 1]), "i"(((f) & 1) * 8192) : "memory")
#define KWT(dst, n) asm volatile("s_waitcnt lgkmcnt(" #n ")" : "+v"(dst) :: "memory")
#define KMM(dst, f) do { if (((f) & 1) == 0) p0 = __builtin_amdgcn_mfma_f32_32x32x16_bf16(dst, qr[(f) >> 1], p0, 0, 0, 0); else p1 = __builtin_amdgcn_mfma_f32_32x32x16_bf16(dst, qr[(f) >> 1], p1, 0, 0, 0); } while (0)
#define KSTEP(dst, f, n) do { KWT(dst, n); SBAR(); KMM(dst, f); SBAR(); if ((f) + 4 < 16) KRD(dst, (f) + 4); } while (0)
        KRD(kb0, 0); KRD(kb1, 1); KRD(kb2, 2); KRD(kb3, 3);
        KSTEP(kb0, 0, 3); KSTEP(kb1, 1, 3); KSTEP(kb2, 2, 3); KSTEP(kb3, 3, 3);
        KSTEP(kb0, 4, 3); KSTEP(kb1, 5, 3); KSTEP(kb2, 6, 3); KSTEP(kb3, 7, 3);
        KSTEP(kb0, 8, 3); KSTEP(kb1, 9, 3); KSTEP(kb2, 10, 3); KSTEP(kb3, 11, 3);
        KSTEP(kb0, 12, 3); KSTEP(kb1, 13, 2); KSTEP(kb2, 14, 1); KSTEP(kb3, 15, 0);
#undef KSTEP
#undef KMM
#undef KWT
#undef KRD
    }
}
__device__ __forceinline__ void pv_tile(f32x16 (&o)[4], unsigned vb, bf16x8 pa0, bf16x8 pa1, bf16x8 pa2, bf16x8 pa3) {
#define TRRD(dst, off) asm volatile("ds_read_b64_tr_b16 %0, %1 offset:%2" : "=&v"(dst) : "v"(vb), "i"(off) : "memory")
#define PV_RD(S, d0) do { constexpr int b_ = v_rd_off(d0, 0, 0); \
        TRRD(S##l0, b_); TRRD(S##h0, b_ + 2048); TRRD(S##l1, b_ + 4096); TRRD(S##h1, b_ + 6144); TRRD(S##l2, b_ + 8192); TRRD(S##h2, b_ + 10240); TRRD(S##l3, b_ + 12288); TRRD(S##h3, b_ + 14336); } while (0)
#define PV_MM(S, d0) do { \
        o[d0] = __builtin_amdgcn_mfma_f32_32x32x16_bf16(pa0, (bf16x8){S##l0[0], S##l0[1], S##l0[2], S##l0[3], S##h0[0], S##h0[1], S##h0[2], S##h0[3]}, o[d0], 0, 0, 0);   \
        o[d0] = __builtin_amdgcn_mfma_f32_32x32x16_bf16(pa1, (bf16x8){S##l1[0], S##l1[1], S##l1[2], S##l1[3], S##h1[0], S##h1[1], S##h1[2], S##h1[3]}, o[d0], 0, 0, 0);   \
        o[d0] = __builtin_amdgcn_mfma_f32_32x32x16_bf16(pa2, (bf16x8){S##l2[0], S##l2[1], S##l2[2], S##l2[3], S##h2[0], S##h2[1], S##h2[2], S##h2[3]}, o[d0], 0, 0, 0);   \
        o[d0] = __builtin_amdgcn_mfma_f32_32x32x16_bf16(pa3, (bf16x8){S##l3[0], S##l3[1], S##l3[2], S##l3[3], S##h3[0], S##h3[1], S##h3[2], S##h3[3]}, o[d0], 0, 0, 0); } while (0)
#define PV_W(n) do { asm volatile("s_waitcnt lgkmcnt(" #n ")" ::: "memory"); SBAR(); } while (0)
    {
        s16x4 Al0, Al1, Al2, Al3, Ah0, Ah1, Ah2, Ah3, Bl0, Bl1, Bl2, Bl3, Bh0, Bh1, Bh2, Bh3;
        PV_RD(A, 0); PV_RD(B, 1); PV_W(8); PV_MM(A, 0); SBAR();
        PV_RD(A, 2); PV_W(8); PV_MM(B, 1); SBAR();
        PV_RD(B, 3); PV_W(8); PV_MM(A, 2); SBAR();
        PV_W(0); PV_MM(B, 3);
    }
#undef PV_RD
#undef PV_MM
#undef PV_W
#undef TRRD
}

__device__ __forceinline__ void attn_prefetch(const bf16* Kg, const bf16* Vg, int j, ALAS unsigned char* lds) {
    int tid = threadIdx.x; asm volatile("" : "+v"(tid));
    const int wid = __builtin_amdgcn_readfirstlane(tid >> 6), lane = tid & 63;
    ALAS char* V_lds = (ALAS char*)lds + A_V; ALAS char* K_lds = (ALAS char*)lds + A_K;
    const char* kp_ = (const char*)(Kg + (size_t)j * 64 * 128); const char* vp_ = (const char*)(Vg + (size_t)j * 64 * 128);
#pragma unroll
    for (int i = 0; i < 2; ++i) { const int L = ((wid * 2 + i) * 64 + lane) * 16;
        const int row = L >> 8, cp = (L >> 4) & 15; const unsigned kof = (unsigned)(row * 256 + ((cp ^ (row & 15)) << 4));
        const int blk = L >> 9, kk = (blk >> 2) * 8 + ((L >> 6) & 7), k = (kk & ~0xC) | ((kk & 4) << 1) | ((kk & 8) >> 1);
        const unsigned vof = (unsigned)(k * 256 + (blk & 3) * 64 + ((L >> 4) & 3) * 16);
        __builtin_amdgcn_global_load_lds((const unsigned*)(kp_ + kof), (ALAS unsigned*)(K_lds + (wid * 2 + i) * 1024), 16, 0, 0);
        __builtin_amdgcn_global_load_lds((const unsigned*)(vp_ + vof), (ALAS unsigned*)(V_lds + (wid * 2 + i) * 1024), 16, 0, 0); }
}
template <int MODE, bool PRE = false>
__device__ __forceinline__ void attn_loop(f32x16 (&o)[4], float& l_out, const bf16x8 (&qr)[8], const bf16* Kg, const bf16* Vg, int j_lo, int j_hi,
                                          int pos, unsigned long long sel, int wpos0, int own, const ALAS float* btab, float c31, ALAS unsigned char* lds) {
    int tid = threadIdx.x; asm volatile("" : "+v"(tid));
    const int wid = __builtin_amdgcn_readfirstlane(tid >> 6), lane = tid & 63, r32 = lane & 31, hi = lane >> 5;
    ALAS char* V_lds = (ALAS char*)lds + A_V; ALAS char* K_lds = (ALAS char*)lds + A_K;
    ALAS float* al_l = (ALAS float*)(lds + A_WS) + wid * 64 + 32;
    const unsigned vb0 = (unsigned)(size_t)V_lds + (unsigned)v_rd_base(lane);
    constexpr int KS = (MODE == M_CMP) ? 16 : 1;
    float m_reg = -1e30f, l_reg = 0.f;
#pragma unroll
    for (int d = 0; d < 4; ++d) o[d] = f32x16{};
    unsigned kof[2], vof[2];
#pragma unroll
    for (int i = 0; i < 2; ++i) { const int L = ((wid * 2 + i) * 64 + lane) * 16;
        const int row = L >> 8, cp = (L >> 4) & 15; kof[i] = (unsigned)(row * 256 + ((cp ^ (row & 15)) << 4));
        const int blk = L >> 9, kk = (blk >> 2) * 8 + ((L >> 6) & 7), k = (kk & ~0xC) | ((kk & 4) << 1) | ((kk & 8) >> 1);
        vof[i] = (unsigned)(k * 256 + (blk & 3) * 64 + ((L >> 4) & 3) * 16); }
#define GSTAGE(j, bf) do { const char* kp_ = (const char*)(Kg + (size_t)(j) * 64 * 128); const char* vp_ = (const char*)(Vg + (size_t)(j) * 64 * 128); \
        _Pragma("unroll") for (int i_ = 0; i_ < 2; ++i_) { \
            __builtin_amdgcn_global_load_lds((const unsigned*)(kp_ + kof[i_]), (ALAS unsigned*)(K_lds + (bf) * SHM_K + (wid * 2 + i_) * 1024), 16, 0, 0); \
            __builtin_amdgcn_global_load_lds((const unsigned*)(vp_ + vof[i_]), (ALAS unsigned*)(V_lds + (bf) * SHM_V + (wid * 2 + i_) * 1024), 16, 0, 0); } } while (0)
    const int NT = j_hi - j_lo;
    if (!PRE) GSTAGE(j_lo, 0);
    asm volatile("s_waitcnt vmcnt(0)" ::: "memory");
    __syncthreads();
    if (wid < 4) __builtin_amdgcn_s_setprio(2);
    for (int t = 0; t < NT; ++t) {
        const int buf = t & 1, j = j_lo + t;
        if (t + 1 < NT) GSTAGE(j + 1, buf ^ 1);
        f32x16 p0, p1;
        qkt<false>(p0, p1, K_lds + buf * SHM_K, r32, hi, qr);
        const int kp0 = (MODE == M_CMP) ? (1024 * j + 31) : 64 * j;
        const int dmin = wpos0 - (kp0 + 63 * KS), dmax = wpos0 + 31 - kp0;
        bool rowsel = true;
        if (MODE == M_SEL) rowsel = ((sel >> j) & 1ull) != 0ull;
        if (MODE == M_MOBA) rowsel = ((j >> 2) < own) ? (((sel >> (j >> 2)) & 1ull) != 0ull) : true;
        float tb;
        if (dmin >= 113 && (MODE != M_WIN || dmax < 512)) { tb = rowsel ? c31 : NEG_INF; }
        else {
            tb = 0.f;
            int dq = pos - kp0 - KS * 4 * hi; asm volatile("" : "+v"(dq));
            const unsigned LIMIT = (MODE == M_WIN) ? 512u : 0x7fffffffu;
#pragma unroll
            for (int r = 0; r < 16; ++r) { if ((r & 3) == 0 && r) SBAR();
                const int c = (r & 3) + 8 * (r >> 2); const int d0 = dq - KS * c, d1 = d0 - KS * 32;
                const int i0 = d0 < 0 ? 0 : (d0 > 127 ? 127 : d0), i1 = d1 < 0 ? 0 : (d1 > 127 ? 127 : d1);
                const float b0 = btab[i0], b1 = btab[i1];
                const float k0 = (rowsel && (unsigned)d0 < LIMIT) ? 0.f : NEG_INF, k1 = (rowsel && (unsigned)d1 < LIMIT) ? 0.f : NEG_INF;
                p0[r] = (p0[r] + b0) + k0; p1[r] = (p1[r] + b1) + k1; }
        }
        float pmax = p0[0];
#pragma unroll
        for (int r = 1; r < 16; ++r) pmax = fmaxf(pmax, p0[r]);
#pragma unroll
        for (int r = 0; r < 16; ++r) pmax = fmaxf(pmax, p1[r]);
        { auto rr = __builtin_amdgcn_permlane32_swap(__float_as_uint(pmax), __float_as_uint(pmax), false, false);
          pmax = fmaxf(__uint_as_float(rr[0]), __uint_as_float(rr[1])); }
        const float cand = pmax + tb;
        float mn, alpha;
        if (__all((cand - m_reg) <= THR)) { mn = m_reg; alpha = 1.f; }
        else { mn = fmaxf(m_reg, cand); alpha = __builtin_amdgcn_exp2f(m_reg - mn); m_reg = mn; }
        const float off = tb - mn;
        float ps = 0.f;
#pragma unroll
        for (int r = 0; r < 16; ++r) { p0[r] = __builtin_amdgcn_exp2f(p0[r] + off); ps += p0[r]; }
#pragma unroll
        for (int r = 0; r < 16; ++r) { p1[r] = __builtin_amdgcn_exp2f(p1[r] + off); ps += p1[r]; }
        { auto rr = __builtin_amdgcn_permlane32_swap(__float_as_uint(ps), __float_as_uint(ps), false, false);
          ps = __uint_as_float(rr[0]) + __uint_as_float(rr[1]); }
        l_reg = l_reg * alpha + ps;
        bf16x8 pa0, pa1, pa2, pa3;
#define PK4(P, B_, OUT) do { unsigned a0 = cvtpk(P[B_+0], P[B_+1]), a1 = cvtpk(P[B_+2], P[B_+3]);                          \
        unsigned b0 = cvtpk(P[B_+4], P[B_+5]), b1 = cvtpk(P[B_+6], P[B_+7]);                                             \
        auto r0 = __builtin_amdgcn_permlane32_swap(a0, b0, false, false); auto r1 = __builtin_amdgcn_permlane32_swap(a1, b1, false, false); \
        u32x4 w = {r0[0], r1[0], r0[1], r1[1]}; OUT = *reinterpret_cast<bf16x8*>(&w); } while (0)
        PK4(p0, 0, pa0); PK4(p0, 8, pa1); PK4(p1, 0, pa2); PK4(p1, 8, pa3);
#undef PK4
        if (__any(alpha < 1.f)) { if (hi == 0) al_l[r32] = alpha; asm volatile("s_waitcnt lgkmcnt(0)" ::: "memory");
#pragma unroll
            for (int d_ = 0; d_ < 4; ++d_)
#pragma unroll
                for (int r = 0; r < 16; ++r) o[d_][r] *= al_l[crow(r, hi)]; }
        SBAR();
        pv_tile(o, vb0 + (unsigned)(buf * SHM_V), pa0, pa1, pa2, pa3);
        asm volatile("s_waitcnt vmcnt(0)" ::: "memory");
        __syncthreads();
    }
#undef GSTAGE
    __builtin_amdgcn_s_setprio(0);
    l_out = l_reg;
}

__device__ __forceinline__ void attn_norm(f32x16 (&o)[4], float l, float fac, ALAS unsigned char* lds) {
    const int tid = threadIdx.x, wid = __builtin_amdgcn_readfirstlane(tid >> 6), lane = tid & 63, r32 = lane & 31, hi = lane >> 5;
    ALAS float* li_l = (ALAS float*)(lds + A_WS) + wid * 64;
    if (hi == 0) li_l[r32] = (l > 0.f) ? fac * __builtin_amdgcn_rcpf(l) : 0.f;
    asm volatile("s_waitcnt lgkmcnt(0)" ::: "memory");
#pragma unroll
    for (int r = 0; r < 16; ++r) { const float f = li_l[crow(r, hi)];
#pragma unroll
        for (int d0 = 0; d0 < 4; ++d0) o[d0][r] *= f; }
    asm volatile("s_waitcnt lgkmcnt(0)" ::: "memory");
}
constexpr int A_ST0 = 65536, A_ST1 = 103424;
template <bool ACC>
__device__ __forceinline__ void attn_store_bf16(const f32x16 (&o)[4], bf16* Ow, int pitch, ALAS unsigned char* lds) {
    int tid_ = threadIdx.x; asm volatile("" : "+v"(tid_));
    const int wid = __builtin_amdgcn_readfirstlane(tid_ >> 6), lane = tid_ & 63, r32 = lane & 31, hi = lane >> 5;
    ALAS unsigned char* S = lds + (wid < 4 ? A_ST0 + wid * 8192 : A_ST1 + (wid - 4) * 8192);
    u32x4 old[8];
    const int row0 = lane >> 4, ch = lane & 15;
    if (ACC) {
#pragma unroll
        for (int k = 0; k < 8; ++k) old[k] = *(const u32x4*)(Ow + (size_t)(4 * k + row0) * pitch + ch * 8);
    }
#pragma unroll
    for (int r = 0; r < 16; ++r)
#pragma unroll
        for (int d0 = 0; d0 < 4; ++d0) { const float v = o[d0][r]; const float vn = quad_xor<1>(v);
            if ((r32 & 1) == 0) *(ALAS unsigned*)(S + crow(r, hi) * 256 + (d0 * 32 + r32) * 2) = cvtpk(v, vn); }
#pragma unroll
    for (int k = 0; k < 8; ++k) { u32x4 w = *(const ALAS u32x4*)(S + (4 * k + row0) * 256 + ch * 16);
        if (ACC) { const u32x4 q = old[k];
            w.x = cvtpk(__uint_as_float(w.x << 16) + __uint_as_float(q.x << 16), __uint_as_float(w.x & 0xffff0000u) + __uint_as_float(q.x & 0xffff0000u));
            w.y = cvtpk(__uint_as_float(w.y << 16) + __uint_as_float(q.y << 16), __uint_as_float(w.y & 0xffff0000u) + __uint_as_float(q.y & 0xffff0000u));
            w.z = cvtpk(__uint_as_float(w.z << 16) + __uint_as_float(q.z << 16), __uint_as_float(w.z & 0xffff0000u) + __uint_as_float(q.z & 0xffff0000u));
            w.w = cvtpk(__uint_as_float(w.w << 16) + __uint_as_float(q.w << 16), __uint_as_float(w.w & 0xffff0000u) + __uint_as_float(q.w & 0xffff0000u)); }
        *(u32x4*)(Ow + (size_t)(4 * k + row0) * pitch + ch * 8) = w; }
}
template <bool ACC>
__device__ __forceinline__ void attn_store_f8(const f32x16 (&o)[4], const bf16* Oold, int pitch, unsigned char* O8, int pitch8, ALAS unsigned char* lds) {
    typedef unsigned u32x2s __attribute__((ext_vector_type(2)));
    int tid_ = threadIdx.x; asm volatile("" : "+v"(tid_));
    const int wid = __builtin_amdgcn_readfirstlane(tid_ >> 6), lane = tid_ & 63, r32 = lane & 31, hi = lane >> 5;
    ALAS unsigned char* S = lds + (wid < 4 ? A_ST0 + wid * 8192 : A_ST1 + (wid - 4) * 8192);
    u32x4 old[8];
    const int row0 = lane >> 4, ch = lane & 15;
    if (ACC) {
#pragma unroll
        for (int k = 0; k < 8; ++k) old[k] = *(const u32x4*)(Oold + (size_t)(4 * k + row0) * pitch + ch * 8);
    }
#pragma unroll
    for (int r = 0; r < 16; ++r)
#pragma unroll
        for (int d0 = 0; d0 < 4; ++d0) { const float v = o[d0][r]; const float vn = quad_xor<1>(v);
            if ((r32 & 1) == 0) *(ALAS unsigned*)(S + crow(r, hi) * 256 + (d0 * 32 + r32) * 2) = cvtpk(v, vn); }
#pragma unroll
    for (int k = 0; k < 8; ++k) { const u32x4 w = *(const ALAS u32x4*)(S + (4 * k + row0) * 256 + ch * 16);
        float f[8] = {__uint_as_float(w.x << 16), __uint_as_float(w.x & 0xffff0000u), __uint_as_float(w.y << 16), __uint_as_float(w.y & 0xffff0000u),
                      __uint_as_float(w.z << 16), __uint_as_float(w.z & 0xffff0000u), __uint_as_float(w.w << 16), __uint_as_float(w.w & 0xffff0000u)};
        if (ACC) { const u32x4 q = old[k];
            f[0] += __uint_as_float(q.x << 16); f[1] += __uint_as_float(q.x & 0xffff0000u); f[2] += __uint_as_float(q.y << 16); f[3] += __uint_as_float(q.y & 0xffff0000u);
            f[4] += __uint_as_float(q.z << 16); f[5] += __uint_as_float(q.z & 0xffff0000u); f[6] += __uint_as_float(q.w << 16); f[7] += __uint_as_float(q.w & 0xffff0000u); }
        int q0 = __builtin_amdgcn_cvt_pk_fp8_f32(f[0] * 16.f, f[1] * 16.f, 0, false); q0 = __builtin_amdgcn_cvt_pk_fp8_f32(f[2] * 16.f, f[3] * 16.f, q0, true);
        int q1 = __builtin_amdgcn_cvt_pk_fp8_f32(f[4] * 16.f, f[5] * 16.f, 0, false); q1 = __builtin_amdgcn_cvt_pk_fp8_f32(f[6] * 16.f, f[7] * 16.f, q1, true);
        u32x2s qq; qq.x = (unsigned)q0; qq.y = (unsigned)q1;
        *(u32x2s*)(O8 + (size_t)(4 * k + row0) * pitch8 + ch * 8) = qq; }
}
__device__ __forceinline__ void load_q(bf16x8 (&qr)[8], const bf16* Qw) {
    int tid_ = threadIdx.x; asm volatile("" : "+v"(tid_));
    const int lane = tid_ & 63, r32 = lane & 31, hi = lane >> 5;
#pragma unroll
    for (int d0 = 0; d0 < 8; ++d0) qr[d0] = *(const bf16x8*)(Qw + (size_t)r32 * 128 + d0 * 16 + hi * 8);
}
}
constexpr int NWAVES = 8;
constexpr int DM = 2048, SEQ = 4096, TOK = 8192, HD = 128;
constexpr int NPROJ = 9984;
constexpr float RMS_EPS = 1e-6f;
constexpr float LOG2E = 1.4426950408889634f;
constexpr float QSCALE = 0.08838834764831845f * 1.4426950408889634f;

constexpr size_t MiB = 1u << 20;
constexpr size_t WS_CTL = 0, CTL_ZERO_BYTES = 64 * 1024;
constexpr size_t WS_WIN_T = 2 * MiB;
constexpr size_t WS_WA_T = 42 * MiB;
constexpr size_t WS_WB_T = 46 * MiB;
constexpr size_t WS_WO_T = 50 * MiB;
constexpr size_t WS_W1K_T = 58 * MiB;
constexpr size_t WS_W1V_T = 60 * MiB;
constexpr size_t WS_WR_T = 62 * MiB;
constexpr size_t WS_CV = 63 * MiB;
constexpr size_t WS_CMPK = WS_CV + 64 * 1024;
constexpr size_t WS_CMPV = WS_CMPK + 256 * 1024;
constexpr size_t WS_OV = WS_CMPV + 256 * 1024;
constexpr size_t WS_KM = WS_OV + 64 * 1024;
constexpr size_t WS_XN = 64 * MiB;
constexpr size_t WS_QA = 96 * MiB;
constexpr size_t WS_KV6 = 112 * MiB;
constexpr size_t WS_QKVB = 136 * MiB;
constexpr size_t WS_GM = 184 * MiB;
constexpr size_t WS_GATE = 248 * MiB;
constexpr size_t WS_SSQ = 249 * MiB;
constexpr size_t WS_P = 420 * MiB;
constexpr size_t WS_OA = 254 * MiB;
constexpr size_t WS_OB = 270 * MiB;
constexpr size_t WS_MRG = 286 * MiB;
constexpr size_t WS_H = 318 * MiB;
constexpr size_t WS_Y = 350 * MiB;
constexpr size_t WS_BKT = 414 * MiB;
constexpr size_t WS_BKTW = 416 * MiB;
constexpr size_t WS_END = 452 * MiB;
constexpr int CW_TMO = 0, CW_CODE = 1, CW_BAR = 4096, CW_CNT = 8192  , CW_ERR = 9216  ;
constexpr int RING_OFF = 0, RING_BYTES = 139264;
constexpr int LDSCTL_OFF = RING_BYTES, MISC_OFF = LDSCTL_OFF, TILES_OFF = LDSCTL_OFF + 256;
constexpr int LDS_BYTES = 147456;
static_assert(TILES_OFF + 128 * 16 <= LDS_BYTES, "LDS map");

#define GAS __attribute__((address_space(1)))
#define LAS __attribute__((address_space(3)))
typedef unsigned short bf16;
typedef unsigned v4u __attribute__((ext_vector_type(4)));
typedef unsigned v2u __attribute__((ext_vector_type(2)));
typedef float f32x4 __attribute__((ext_vector_type(4)));
typedef short bf16x8 __attribute__((ext_vector_type(8)));
typedef GAS unsigned gu32;
#define RLX_AGENT __ATOMIC_RELAXED, __HIP_MEMORY_SCOPE_AGENT
#define LDS_WAIT() asm volatile("s_waitcnt lgkmcnt(0)" ::: "memory")
#define VM_WAIT() asm volatile("s_waitcnt vmcnt(0)" ::: "memory")
__device__ __forceinline__ unsigned f2bf(float f) { unsigned u = __builtin_bit_cast(unsigned, f); return (u + 0x7fffu + ((u >> 16) & 1u)) >> 16; }
__device__ __forceinline__ unsigned pk2(float lo, float hi) { return f2bf(lo) | (f2bf(hi) << 16); }
__device__ __forceinline__ float bf2f(unsigned h) { return __uint_as_float(h << 16); }

#define XB_TMO      128
#define XB_XCNT(j)  (256  + 64 * (j))
#define XB_XSUB(j)  (1280 + 64 * (j))
#define XB_XGEN(j)  (2304 + 64 * (j))
#define XB_TOP      3328
#define XB_TOPGEN   3392
#define XCD_BAR_WORDS 3456
#define XB_SPIN_CAP (1u << 18)
__device__ __forceinline__ unsigned xb_ld(unsigned* p)              { return __hip_atomic_load(p, __ATOMIC_RELAXED, __HIP_MEMORY_SCOPE_AGENT); }
__device__ __forceinline__ unsigned xb_add(unsigned* p, unsigned v) { return __hip_atomic_fetch_add(p, v, __ATOMIC_RELAXED, __HIP_MEMORY_SCOPE_AGENT); }
__device__ __forceinline__ unsigned xb_xcc_id() { return (unsigned)__builtin_amdgcn_s_getreg((3 << 11) | 20) & 0xFu; }
#define XB_SPIN(cond, bar) do { unsigned _sp = 0; while (cond) { __builtin_amdgcn_s_sleep(1); \
    if ((++_sp & 255u) == 0u) { if (xb_ld(&(bar)[XB_TMO])) break; if (_sp > XB_SPIN_CAP) { atomicAdd(&(bar)[XB_TMO], 1u); break; } } } } while (0)
struct XcdBarrier { unsigned* bar; unsigned x; volatile LAS unsigned* st; };
__device__ __forceinline__ XcdBarrier xcd_barrier_post(unsigned* bar, volatile LAS unsigned* st) {
    XcdBarrier b; b.bar = bar; b.x = xb_xcc_id(); b.st = st;
    if (threadIdx.x == 0) (void)xb_add(&bar[XB_XCNT(b.x)], 1u);
    return b;
}
__device__ __forceinline__ void xcd_barrier_complete(unsigned* bar, unsigned x, unsigned& nloc, unsigned& nx) {
    const unsigned G = gridDim.x * gridDim.y * gridDim.z;
    unsigned sum, cnt, mine, sp = 0u;
    for (;;) {
        sum = 0u; cnt = 0u; mine = 0u;
#pragma unroll
        for (unsigned j = 0; j < 16; ++j) { const unsigned c = xb_ld(&bar[XB_XCNT(j)]); sum += c; cnt += (c > 0u) ? 1u : 0u; mine = (j == x) ? c : mine; }
        if (sum == G) break;
        __builtin_amdgcn_s_sleep(1);
        if ((++sp & 255u) == 0u) { if (xb_ld(&bar[XB_TMO])) break; if (sp > XB_SPIN_CAP) { atomicAdd(&bar[XB_TMO], 1u); break; } }
    }
    nloc = mine > 0u ? mine : 1u; nx = cnt > 0u ? cnt : 1u;
}
__device__ __forceinline__ void xcd_barrier(const XcdBarrier& b) {
    asm volatile("s_waitcnt vmcnt(0)" ::: "memory");
    __syncthreads();
    if (threadIdx.x == 0) {
        unsigned* bar = b.bar;
        __builtin_amdgcn_s_waitcnt(0);
        unsigned nloc = b.st[0], nx = b.st[1];
        if (nloc == 0u) { xcd_barrier_complete(bar, b.x, nloc, nx); b.st[0] = nloc; b.st[1] = nx; }
        const unsigned old = xb_add(&bar[XB_XSUB(b.x)], 1u);
        const unsigned gen = old / nloc;
        if (old + 1u == (gen + 1u) * nloc) {
            __builtin_amdgcn_fence(__ATOMIC_RELEASE, "agent");
            asm volatile("s_waitcnt vmcnt(0)" ::: "memory");
            const unsigned og = xb_add(&bar[XB_TOP], 1u);
            const unsigned tg = og / nx;
            if (og + 1u == (tg + 1u) * nx) xb_add(&bar[XB_TOPGEN], 1u);
            else XB_SPIN(xb_ld(&bar[XB_TOPGEN]) == tg, bar);
            __builtin_amdgcn_fence(__ATOMIC_ACQUIRE, "agent");
            xb_add(&bar[XB_XGEN(b.x)], 1u);
            asm volatile("s_waitcnt vmcnt(0)" ::: "memory");
        } else {
            XB_SPIN(xb_ld(&bar[XB_XGEN(b.x)]) == gen, bar);
            __builtin_amdgcn_fence(__ATOMIC_ACQUIRE, "agent");
            asm volatile("s_waitcnt vmcnt(0)" ::: "memory");
        }
    }
    __syncthreads();
}

__device__ __forceinline__ float wave_sum(float v) {
#pragma unroll
    for (int o = 1; o < 64; o <<= 1) v += __shfl_xor(v, o);
    return v;
}
__device__ __forceinline__ int rel_bucket(int n) {
    if (n < 16) return n;
    return 16 + (n >= 19) + (n >= 21) + (n >= 24) + (n >= 27) + (n >= 31) + (n >= 35) + (n >= 40) + (n >= 46) + (n >= 52) + (n >= 59) + (n >= 67) + (n >= 77) + (n >= 87) + (n >= 99) + (n >= 113);
}
__device__ __forceinline__ int wcol_src(int n) { return n < 2560 ? n : (n < 9728 ? n + 24 : (n < 9752 ? n - 9728 + 2560 : -1)); }

__device__ __forceinline__ void tr_item64(const float* src, int ldw, int scol4, float sc, bf16* dst, int ldk, LAS float* scr, int lane) {
    const int n4 = lane & 15, kk = lane >> 4;
    f32x4 v[16];
#pragma unroll
    for (int i = 0; i < 16; ++i) v[i] = scol4 >= 0 ? *(const GAS f32x4*)(src + (size_t)(4 * i + kk) * ldw + scol4) : (f32x4){0.f, 0.f, 0.f, 0.f};
    __builtin_amdgcn_sched_barrier(0);
#pragma unroll
    for (int i = 0; i < 16; ++i) *(LAS f32x4*)(scr + (4 * i + kk) * 68 + 4 * n4) = v[i] * sc;
    LDS_WAIT(); asm volatile("" ::: "memory");
    const int c = lane & 7;
#pragma unroll
    for (int j = 0; j < 8; ++j) { const int n = (lane >> 3) + 8 * j; const LAS float* s = scr + (8 * c) * 68 + n;
        v4u o; o.x = pk2(s[0 * 68], s[1 * 68]); o.y = pk2(s[2 * 68], s[3 * 68]); o.z = pk2(s[4 * 68], s[5 * 68]); o.w = pk2(s[6 * 68], s[7 * 68]);
        *(GAS v4u*)(dst + (size_t)n * ldk + 8 * c) = o; }
    LDS_WAIT(); asm volatile("" ::: "memory");
}
__device__ __forceinline__ void tr_item64_f8(const float* src, int ldw, int scol4, float sc, unsigned char* dst, int ldk, LAS float* scr, int lane) {
    const int n4 = lane & 15, kk = lane >> 4;
    f32x4 v[16];
#pragma unroll
    for (int i = 0; i < 16; ++i) v[i] = scol4 >= 0 ? *(const GAS f32x4*)(src + (size_t)(4 * i + kk) * ldw + scol4) : (f32x4){0.f, 0.f, 0.f, 0.f};
    __builtin_amdgcn_sched_barrier(0);
#pragma unroll
    for (int i = 0; i < 16; ++i) *(LAS f32x4*)(scr + (4 * i + kk) * 68 + 4 * n4) = v[i] * sc;
    LDS_WAIT(); asm volatile("" ::: "memory");
    const int c = lane & 3;
#pragma unroll
    for (int j = 0; j < 4; ++j) { const int n = (lane >> 2) + 16 * j; const LAS float* s = scr + (16 * c) * 68 + n; v4u o;
        { int q = __builtin_amdgcn_cvt_pk_fp8_f32(s[0 * 68], s[1 * 68], 0, false); q = __builtin_amdgcn_cvt_pk_fp8_f32(s[2 * 68], s[3 * 68], q, true); o.x = (unsigned)q; }
        { int q = __builtin_amdgcn_cvt_pk_fp8_f32(s[4 * 68], s[5 * 68], 0, false); q = __builtin_amdgcn_cvt_pk_fp8_f32(s[6 * 68], s[7 * 68], q, true); o.y = (unsigned)q; }
        { int q = __builtin_amdgcn_cvt_pk_fp8_f32(s[8 * 68], s[9 * 68], 0, false); q = __builtin_amdgcn_cvt_pk_fp8_f32(s[10 * 68], s[11 * 68], q, true); o.z = (unsigned)q; }
        { int q = __builtin_amdgcn_cvt_pk_fp8_f32(s[12 * 68], s[13 * 68], 0, false); q = __builtin_amdgcn_cvt_pk_fp8_f32(s[14 * 68], s[15 * 68], q, true); o.w = (unsigned)q; }
        *(GAS v4u*)(dst + (size_t)n * ldk + 16 * c) = o; }
    LDS_WAIT(); asm volatile("" ::: "memory");
}
__device__ __forceinline__ void rms_row_to_fp8(const float* xrow, const float* gain, unsigned char* orow, int lane) {
    const GAS f32x4* xr = (const GAS f32x4*)xrow + lane; const GAS f32x4* gr = (const GAS f32x4*)gain + lane;
    f32x4 v[8], gv[8]; float s = 0.f;
#pragma unroll
    for (int j = 0; j < 8; ++j) { v[j] = xr[64 * j]; gv[j] = gr[64 * j]; s += (v[j].x * v[j].x + v[j].y * v[j].y) + (v[j].z * v[j].z + v[j].w * v[j].w); }
    const float rstd = 1.f / sqrtf(wave_sum(s) * (1.f / DM) + RMS_EPS);
    GAS unsigned* o4 = (GAS unsigned*)orow + lane;
#pragma unroll
    for (int j = 0; j < 8; ++j) { const f32x4 g = gv[j]; int q = __builtin_amdgcn_cvt_pk_fp8_f32(v[j].x * rstd * g.x, v[j].y * rstd * g.y, 0, false); q = __builtin_amdgcn_cvt_pk_fp8_f32(v[j].z * rstd * g.z, v[j].w * rstd * g.w, q, true); o4[64 * j] = (unsigned)q; }
}
__device__ __forceinline__ float gelu_tanh(float x) {
    const float u = 0.7978845608028654f * (x + 0.044715f * x * x * x);
    const float e = __builtin_amdgcn_exp2f(2.f * LOG2E * u);
    const float th = 1.f - 2.f * __builtin_amdgcn_rcpf(e + 1.f);
    return 0.5f * x * (1.f + th);
}
struct Args { const float* in[22]; float* out; unsigned char* ws; };
enum { I_X = 0, I_REL = 1, I_NMIX = 2, I_WIN = 3, I_PEK = 4, I_W1K = 5, I_W2K = 6, I_PEV = 7, I_W1V = 8, I_W2V = 9, I_WUPA = 10, I_WUPB = 11, I_WOUT = 12, I_NFFN = 13,
       I_WGRP = 14, I_BGRP = 15, I_WRT = 16, I_BRT = 17, I_WEG = 18, I_WEU = 19, I_WED = 20, I_NFIN = 21 };

__device__ __forceinline__ void build_btab(LAS unsigned char* lds, const float* rel, int hcol0, int nh, int tid) {
    LAS float* bt = (LAS float*)(lds + att::A_BT);
    if (tid < nh * 128) { const int jj = tid >> 7, d = tid & 127; bt[tid] = rel[rel_bucket(d) * 16 + hcol0 + jj] * LOG2E; }
}

__global__ void __launch_bounds__(NWAVES * 64, 2) fwd_kernel(Args args) {
    extern __shared__ __attribute__((aligned(16))) unsigned char lds_raw[];
    LAS unsigned char* lds = (LAS unsigned char*)lds_raw;
    volatile LAS unsigned* MISC = (volatile LAS unsigned*)(lds + MISC_OFF);
    const int tid = threadIdx.x, lane = tid & 63, wave = __builtin_amdgcn_readfirstlane(tid >> 6);
    const int G = gridDim.x; const int bx = blockIdx.x; const int vcu = (G % 8 == 0) ? (bx % 8) * (G / 8) + bx / 8 : bx;
    unsigned char* ws = args.ws;
    gu32* ctl = (gu32*)(ws + WS_CTL);
    for (int u = tid; u < (LDS_BYTES - LDSCTL_OFF) / 4; u += NWAVES * 64) ((LAS unsigned*)(lds + LDSCTL_OFF))[u] = 0u;
    __syncthreads();
    XcdBarrier bar = xcd_barrier_post((unsigned*)(ctl + CW_BAR), MISC + 8);
#define GRID_BAR() xcd_barrier(bar)

    const float* x = args.in[I_X]; float* out = args.out;
    bf16* WIN_T = (bf16*)(ws + WS_WIN_T); bf16* WA_T = (bf16*)(ws + WS_WA_T); bf16* WB_T = (bf16*)(ws + WS_WB_T); bf16* WO_T = (bf16*)(ws + WS_WO_T);
    bf16* W1K_T = (bf16*)(ws + WS_W1K_T); bf16* W1V_T = (bf16*)(ws + WS_W1V_T); bf16* WR_T = (bf16*)(ws + WS_WR_T); unsigned char* OA8 = ws + WS_XN; unsigned char* OB8 = ws + WS_XN + 8 * MiB;
    float* CV = (float*)(ws + WS_CV); bf16* CMPK = (bf16*)(ws + WS_CMPK); bf16* CMPV = (bf16*)(ws + WS_CMPV); bf16* OV = (bf16*)(ws + WS_OV); bf16* KM = (bf16*)(ws + WS_KM);
    bf16* XN = (bf16*)(ws + WS_XN); bf16* QA = (bf16*)(ws + WS_QA); bf16* KV6 = (bf16*)(ws + WS_KV6); bf16* QKVB = (bf16*)(ws + WS_QKVB); bf16* GM = (bf16*)(ws + WS_GM);
    float* SSQ = (float*)(ws + WS_SSQ); float* GATE = (float*)(ws + WS_GATE); float* PB = (float*)(ws + WS_P); bf16* OA = (bf16*)(ws + WS_OA); bf16* OB = (bf16*)(ws + WS_OB); bf16* MRG = (bf16*)(ws + WS_MRG);
    bf16* HB = (bf16*)(ws + WS_H); bf16* YB = (bf16*)(ws + WS_Y); int* BKT = (int*)(ws + WS_BKT); float* BKTW = (float*)(ws + WS_BKTW);
    const int gw = vcu * NWAVES + wave, NGW = G * NWAVES;

    {
        LAS float* scr = (LAS float*)(lds + RING_OFF + wave * 17408);
        constexpr int N_WIN = 32 * 156, N_W1 = 4 * 32 * 4, N_RUN = N_WIN + N_W1;
        const int l4 = 4 * (lane & 15);
        for (int it = gw; it < N_RUN; it += NGW) {
            if (it < N_WIN) { const int kb = it / 156, nb = it % 156, n = 64 * nb + l4;
                tr_item64_f8(args.in[I_WIN] + (size_t)(64 * kb) * 9752, 9752, wcol_src(n), ((nb < 16 || (nb >= 40 && nb < 56)) ? QSCALE : 1.f) * 64.f, (unsigned char*)WIN_T + (size_t)(64 * nb) * 2048 + 64 * kb, 2048, scr, lane); }
            else { const int r = it - N_WIN, mat = r >> 7, kb = (r >> 2) & 31, nb = r & 3;
                const float* src = args.in[(mat & 2) ? I_W1V : I_W1K] + (size_t)((mat & 1) * 2048 + 64 * kb) * 256;
                tr_item64(src, 256, 64 * nb + l4, 1.f, ((mat & 2) ? W1V_T : W1K_T) + (size_t)((mat & 1) * 256 + 64 * nb) * 2048 + 64 * kb, 2048, scr, lane); }
        }
        for (int m = gw; m < TOK; m += NGW) rms_row_to_fp8(x + (size_t)m * DM, args.in[I_NMIX], (unsigned char*)XN + (size_t)m * DM, lane);
        const int gt = vcu * (NWAVES * 64) + tid, NGT = G * NWAVES * 64;
        for (int i = gt; i < 256 * 128; i += NGT) { const int c = i >> 7, n = i & 127; OV[i] = (n < 64 && c < 255 && c >= 4 * n - 1 && c <= 4 * n + 3) ? (bf16)0x3f80 : (bf16)0; }
        if (gw < 128) { const int job = gw >> 2, kv = job >> 4, p = job & 15, n = (gw & 3) * 64 + lane; const float* pe = args.in[kv ? I_PEV : I_PEK] + 256 * p; const float* w1 = args.in[kv ? I_W1V : I_W1K] + (size_t)(256 * p) * 256 + n;
            float a = 0.f;
#pragma unroll 32
            for (int k = 0; k < 256; ++k) a += pe[k] * w1[(size_t)k * 256];
            CV[(kv * 16 + p) * 256 + n] = a; }
    }
    GRID_BAR();

    {
        pg8::StaticOrder S; S.init(XN, WIN_T, TOK, NPROJ, DM / 2, G, bx);
        pg8::EpiProj E{QA, KV6, QKVB, GM, GATE};
        pg8::gemm_phase<pg8::EpiProj, pg8::StaticOrder, false, false, true>(lds + RING_OFF, DM / 2, S, E);
    }
    GRID_BAR();

    {
        if (bx < 128) {
            pg8::SplitKOrder S{(const char*)KV6, (const char*)W1K_T, (const char*)W1V_T, bx};
            pg8::EpiF32Split E{PB};
            pg8::gemm_phase<pg8::EpiF32Split, pg8::SplitKOrder, false, false>(lds + RING_OFF, 256, S, E, 2048);
        } else {
            LAS float* red = (LAS float*)(lds + RING_OFF);
            const bf16* KBp = QKVB + 8388608u;
            for (int job = bx - 128; job < 256; job += G - 128) {
                const int bh = job >> 4, blk = job & 15, q = tid >> 7, d = tid & 127;
                const bf16* p = KBp + ((size_t)bh * 4096 + 256 * blk + 64 * q) * 128 + d; float a = 0.f;
#pragma unroll
                for (int i = 0; i < 64; ++i) a += bf2f(p[(size_t)i * 128]);
                red[tid] = a; __syncthreads();
                if (tid < 128) { const float s = (red[tid] + red[tid + 128]) + (red[tid + 256] + red[tid + 384]);
                    KM[((size_t)bh * 32 + blk) * 128 + tid] = (bf16)f2bf(s * (1.f / 256.f)); KM[((size_t)bh * 32 + 16 + blk) * 128 + tid] = (bf16)0; }
                __syncthreads();
            }
            {
                LAS float* scr = (LAS float*)(lds + RING_OFF + wave * 17408);
                const int l4 = 4 * (lane & 15), gw2 = (bx - 128) * NWAVES + wave, NGW2 = (G - 128) * NWAVES;
                for (int it = gw2; it < 2048; it += NGW2) {
                    if (it < 1024) { const bool second = it >= 512; const int r = it & 511, kb = r >> 5, nb = r & 31;
                        tr_item64_f8(args.in[second ? I_WUPB : I_WUPA] + (size_t)(64 * kb) * 2048, 2048, 64 * nb + l4, 64.f, (unsigned char*)(second ? WB_T : WA_T) + (size_t)(64 * nb) * 1024 + 64 * kb, 1024, scr, lane); }
                    else { const int r = it - 1024, kb = r >> 5, nb = r & 31;
                        tr_item64_f8(args.in[I_WOUT] + (size_t)(64 * kb) * 2048, 2048, 64 * nb + l4, 64.f, (unsigned char*)WO_T + (size_t)(64 * nb) * 2048 + 64 * kb, 2048, scr, lane); }
                }
                const int gt = (bx - 128) * (NWAVES * 64) + tid, NGT = (G - 128) * NWAVES * 64;
                for (int i = gt; i < 80 * 2048; i += NGT) { const int n = i >> 11, k = i & 2047; float v = 0.f;
                    if (n < 8) v = args.in[I_WGRP][k * 8 + n]; else if (n < 72) v = args.in[I_WRT][(size_t)((n - 8) >> 3) * 2048 * 8 + k * 8 + ((n - 8) & 7)];
                    WR_T[i] = (bf16)f2bf(v); }
            }
        }
    }
    GRID_BAR();
    {
        LAS float* hid = (LAS float*)(lds + RING_OFF);
        LAS float* cvs = hid + 8 * 256;
        LAS unsigned* w2s = (LAS unsigned*)(cvs + 256);
        for (int item = vcu; item < 256; item += G) {
            const int kv = item >> 7, R0 = (item & 127) * 8; const float* P = PB + (size_t)kv * 8 * 1024 * 512;
            { const GAS f32x4* w2g = (const GAS f32x4*)args.in[kv ? I_W2V : I_W2K];
              f32x4 wv[16];
#pragma unroll
              for (int i = 0; i < 16; ++i) wv[i] = w2g[tid + 512 * i];
              __builtin_amdgcn_sched_barrier(0);
#pragma unroll
              for (int i = 0; i < 16; ++i) { const int q = tid + 512 * i; w2s[2 * q] = pk2(wv[i].x, wv[i].y); w2s[2 * q + 1] = pk2(wv[i].z, wv[i].w); } }
            if (tid < 256) { float a = 0.f;
#pragma unroll
                for (int p = 0; p < 16; ++p) a += CV[(kv * 16 + p) * 256 + tid];
                cvs[tid] = a; }
            __syncthreads();
            for (int e = tid; e < 8 * 256; e += NWAVES * 64) { const int row = e >> 8, n = e & 255, R = R0 + row; float h = 0.f;
                if ((R & 255) < 255) { float a = cvs[n];
#pragma unroll
                    for (int ks = 0; ks < 8; ++ks) a += P[(size_t)ks * 1024 * 512 + (size_t)R * 512 + n] + P[(size_t)ks * 1024 * 512 + (size_t)(R + 1) * 512 + 256 + n];
                    h = gelu_tanh(a); }
                hid[e] = h; }
            __syncthreads();
            { const int row = tid >> 6, R = R0 + row; float a0 = 0.f, a1 = 0.f;
#pragma unroll 8
              for (int k = 0; k < 256; ++k) { const float hv = hid[row * 256 + k]; const unsigned w = w2s[k * 64 + lane]; a0 += hv * bf2f(w & 0xffffu); a1 += hv * __uint_as_float(w & 0xffff0000u); }
              *(GAS unsigned*)((kv ? CMPV : CMPK) + (size_t)R * 128 + 2 * lane) = pk2(a0, a1); }
            __syncthreads();
        }
    }
    GRID_BAR();

    for (int idx = vcu; idx < 256; idx += G) {
      int tid_l = threadIdx.x; asm volatile("" : "+v"(tid_l));
      const int tid = tid_l, lane = tid & 63;
      { const int u = idx;
        const int b = u >> 7, g = (u >> 6) & 1, cur = u & 63, t0 = 64 * cur;
        const int jh = wave >> 1, wpos0 = t0 + 32 * (wave & 1), r32 = lane & 31, hi = lane >> 5, pos = wpos0 + r32, h = g * 4 + jh;
        build_btab(lds, args.in[I_REL], g * 4, 4, tid);
        __syncthreads();
        const LAS float* btab = (const LAS float*)(lds + att::A_BT) + jh * 128; const float c31 = btab[127];
        att::bf16x8 qr[8]; att::load_q(qr, QA + ((size_t)(b * 8 + h) * 4096 + wpos0) * 128);
        const bf16* Kc = CMPK + (size_t)(b * 2 + g) * 256 * 128; const bf16* Vc = CMPV + (size_t)(b * 2 + g) * 256 * 128;
        const int j_hi = ((4 * cur + 2) >> 6) + 1;
        att::f32x16 o[4]; float l;
        const float gate_cmp = GATE[(size_t)(b * 4096 + pos) * 32 + h * 3 + 0];
        att::attn_loop<att::M_CMP>(o, l, qr, Kc, Vc, 0, j_hi, pos, 0ull, wpos0, 0, btab, c31, lds);
        att::attn_prefetch(Kc, OV, 0, lds);
        att::attn_norm(o, l, gate_cmp, lds);
        att::attn_store_bf16<false>(o, OA + (size_t)(b * 4096 + wpos0) * 1024 + h * 128, 1024, lds);
        att::attn_loop<att::M_CMP, true>(o, l, qr, Kc, OV, 0, j_hi, pos, 0ull, wpos0, 0, btab, c31, lds);
        att::attn_norm(o, l, 1.f, lds);
        { LAS float* U = (LAS float*)(lds + att::A_U);
#pragma unroll
          for (int r = 0; r < 16; ++r) { const int orow = att::crow(r, hi); U[(wave * 32 + orow) * 65 + r32] = o[0][r]; U[(wave * 32 + orow) * 65 + 32 + r32] = o[1][r]; } }
        __syncthreads();
        if (wave < 2) {
            const int qi = 32 * wave + r32;
            unsigned long long mask;
            if (cur <= 15) mask = (2ull << cur) - 1ull;
            else {
                const LAS float* U = (const LAS float*)(lds + att::A_U);
                int key[31];
#pragma unroll
                for (int i = 0; i < 31; ++i) { const int n = 1 + i + 31 * hi;
                    const float sc = ((U[qi * 65 + n] + U[(64 + qi) * 65 + n]) + (U[(128 + qi) * 65 + n] + U[(192 + qi) * 65 + n])) + ((n <= cur - 2) ? 0.f : att::NEG_INF);
                    const int bts = __float_as_int(sc), mono = bts ^ ((bts >> 31) & 0x7fffffff); key[i] = (mono & ~63) | (63 - n); }
                mask = 1ull | (3ull << (cur - 1));
                for (int it = 0; it < 13; ++it) { int m = key[0];
#pragma unroll
                    for (int i = 1; i < 31; ++i) m = key[i] > m ? key[i] : m;
                    { auto rr = __builtin_amdgcn_permlane32_swap((unsigned)m, (unsigned)m, false, false); const int m0 = (int)rr[0], m1 = (int)rr[1]; m = m0 > m1 ? m0 : m1; }
                    mask |= 1ull << (63 - (m & 63));
#pragma unroll
                    for (int i = 0; i < 31; ++i) key[i] = (key[i] == m) ? (int)0x80000000 : key[i]; }
            }
            if (hi == 0) ((LAS unsigned long long*)(lds + att::A_MISC))[qi] = mask;
        }
        __syncthreads();
      }
        {
            const int bg = idx >> 6, b = bg >> 1, g = bg & 1, cur = idx & 63, t0 = 64 * cur;
            const int jh = wave >> 1, wpos0 = t0 + 32 * (wave & 1), r32 = lane & 31, pos = wpos0 + r32, h = g * 4 + jh;
            const LAS float* btab = (const LAS float*)(lds + att::A_BT) + jh * 128; const float c31 = btab[127];
            att::attn_prefetch(KV6 + 2 * 2097152u + (size_t)bg * 4096 * 128, KV6 + 3 * 2097152u + (size_t)bg * 4096 * 128, 0, lds);
            att::bf16x8 qr[8]; att::load_q(qr, QA + ((size_t)(b * 8 + h) * 4096 + wpos0) * 128);
            const unsigned long long sel = ((const LAS unsigned long long*)(lds + att::A_MISC))[pos - t0];
            const size_t kvoff = (size_t)bg * 4096 * 128;
            att::f32x16 o[4]; float l;
            const float gate_sel = GATE[(size_t)(b * 4096 + pos) * 32 + h * 3 + 1], gate_win = GATE[(size_t)(b * 4096 + pos) * 32 + h * 3 + 2];
            att::attn_loop<att::M_SEL, true>(o, l, qr, KV6 + 2 * 2097152u + kvoff, KV6 + 3 * 2097152u + kvoff, 0, cur + 1, pos, sel, wpos0, 0, btab, c31, lds);
            const int jw0 = cur > 8 ? cur - 8 : 0;
            att::attn_prefetch(KV6 + 4 * 2097152u + kvoff, KV6 + 5 * 2097152u + kvoff, jw0, lds);
            att::attn_norm(o, l, gate_sel, lds);
            att::attn_store_bf16<true>(o, OA + (size_t)(b * 4096 + wpos0) * 1024 + h * 128, 1024, lds);
            VM_WAIT();
            att::attn_loop<att::M_WIN, true>(o, l, qr, KV6 + 4 * 2097152u + kvoff, KV6 + 5 * 2097152u + kvoff, jw0, cur + 1, pos, 0ull, wpos0, 0, btab, c31, lds);
            { const int bh_m = (cur & 3) * 4 + (idx >> 6); const size_t kvm = (size_t)bh_m * 4096 * 128;
              att::attn_prefetch(QKVB + 8388608u + kvm, QKVB + 2 * 8388608u + kvm, 0, lds); }
            att::attn_norm(o, l, gate_win, lds);
            att::attn_store_f8<true>(o, OA + (size_t)(b * 4096 + wpos0) * 1024 + h * 128, 1024, OA8 + (size_t)(b * 4096 + wpos0) * 1024 + h * 128, 1024, lds);
        }
        __syncthreads();
        {
            const int cur = idx & 63, own = 15 - (cur >> 2), bh = (cur & 3) * 4 + (idx >> 6), b = bh >> 3, h = bh & 7, t0 = 256 * own;
            const int wpos0 = t0 + 32 * wave, r32 = lane & 31, hi = lane >> 5, pos = wpos0 + r32;
            build_btab(lds, args.in[I_REL], 8 + h, 1, tid);
            { LAS unsigned char* K_lds = lds + att::A_K; const int sr = tid >> 4, sc = (tid & 15) * 8;
              *(LAS att::bf16x8*)(K_lds + att::SHM_K + KSWZ(sr, sc * 2)) = *(const att::bf16x8*)(KM + ((size_t)bh * 32 + sr) * 128 + sc); }
            __syncthreads();
            const LAS float* btab = (const LAS float*)(lds + att::A_BT); const float c31 = btab[127];
            att::bf16x8 qr[8]; att::load_q(qr, QKVB + ((size_t)bh * 4096 + wpos0) * 128);
            unsigned long long sel = 0ull;
            { att::f32x16 p0, p1; att::qkt<true>(p0, p1, (const LAS char*)(lds + att::A_K + att::SHM_K), r32, hi, qr);
              float gsc[16];
#pragma unroll
              for (int q = 0; q < 4; ++q)
#pragma unroll
                  for (int i = 0; i < 4; ++i) { const float ownv = p0[(q >> 1) * 4 + i], oth = __shfl_xor(ownv, 32); gsc[4 * q + i] = (hi == (q & 1)) ? ownv : oth; }
#pragma unroll
              for (int n = 0; n < 16; ++n) if (n >= own) gsc[n] = att::NEG_INF;
              for (int it = 0; it < 3; ++it) { float best = att::NEG_INF; int bi = -1;
#pragma unroll
                  for (int n = 0; n < 16; ++n) if (gsc[n] > best) { best = gsc[n]; bi = n; }
                  if (bi >= 0) sel |= 1ull << bi;
#pragma unroll
                  for (int n = 0; n < 16; ++n) if (n == bi) gsc[n] = att::NEG_INF; } }
            __syncthreads();
            const size_t kvoff = (size_t)bh * 4096 * 128;
            att::f32x16 o[4]; float l;
            att::attn_loop<att::M_MOBA, true>(o, l, qr, QKVB + 8388608u + kvoff, QKVB + 2 * 8388608u + kvoff, 0, 4 * own + 4, pos, sel, wpos0, own, btab, c31, lds);
            att::attn_norm(o, l, 1.f, lds);
            att::attn_store_f8<false>(o, nullptr, 0, OB8 + (size_t)(b * 4096 + wpos0) * 1024 + h * 128, 1024, lds);
        }
        __syncthreads();
    }
    GRID_BAR();

    {
        int k6 = 512; asm volatile("" : "+s"(k6));
        { pg8::StaticOrder S; S.init(OA8, WA_T, TOK, DM, k6, G, bx); pg8::EpiGated<false, true> E{MRG, GM, nullptr};
          pg8::gemm_phase<pg8::EpiGated<false, true>, pg8::StaticOrder, false, false, true, 123>(lds + RING_OFF, k6, S, E); }
        { pg8::StaticOrder S; S.init(OB8, WB_T, TOK, DM, k6, G, bx); pg8::EpiGated<true, true> E{MRG, GM + 16777216u, (unsigned char*)HB};
          pg8::gemm_phase<pg8::EpiGated<true, true>, pg8::StaticOrder, false, false, true, 123>(lds + RING_OFF, k6, S, E); }
    }
    GRID_BAR();
    {
        pg8::StaticOrder S; S.init(HB, WO_T, TOK, DM, DM / 2, G, bx); pg8::EpiF32 E{out, DM, x, SSQ};
        pg8::gemm_phase<pg8::EpiF32, pg8::StaticOrder, false, false, true>(lds + RING_OFF, DM / 2, S, E);
    }
    GRID_BAR();
    {
        int tid_ = threadIdx.x; asm volatile("" : "+v"(tid_)); const int tid = tid_, lane = tid_ & 63;
        LAS float* rs = (LAS float*)(lds + RING_OFF);
        LAS float* part = rs + 64;
        LAS float* logit = part + 8 * 32 * 80;
        const bf16* WRH = WR_T;
        LAS float* rbias = logit + 32 * 80;
        if (tid < 72) rbias[tid] = tid < 8 ? args.in[I_BGRP][tid] : args.in[I_BRT][tid - 8];
        for (int it = vcu; it < TOK / 32; it += G) {
            const int m0 = 32 * it;
            if (tid < 32) { float pq[32];
#pragma unroll
                for (int q = 0; q < 32; ++q) pq[q] = SSQ[(size_t)q * 8192 + m0 + tid];
                float a = 0.f;
#pragma unroll
                for (int q = 0; q < 32; ++q) a += pq[q];
                rs[tid] = 1.f / sqrtf(a * (1.f / DM) + RMS_EPS); }
            __syncthreads();
            pg8::f32x4 acc[2][5];
#pragma unroll
            for (int a = 0; a < 2; ++a)
#pragma unroll
                for (int n = 0; n < 5; ++n) acc[a][n] = (pg8::f32x4){0.f, 0.f, 0.f, 0.f};
            const float rstd0 = rs[lane & 15], rstd1 = rs[16 + (lane & 15)];
#pragma unroll 4
            for (int ks = 0; ks < 8; ++ks) { const int k0 = 256 * wave + 32 * ks + 8 * (lane >> 4);
                const f32x4 g0 = *(const GAS f32x4*)(args.in[I_NFFN] + k0), g1 = *(const GAS f32x4*)(args.in[I_NFFN] + k0 + 4);
                bf16x8 ahi[2], alo[2];
#pragma unroll
                for (int a = 0; a < 2; ++a) { const size_t tok = (size_t)(m0 + 16 * a + (lane & 15)); const float rstd = a ? rstd1 : rstd0;
                    f32x4 a0 = *(const GAS f32x4*)(out + tok * DM + k0), a1 = *(const GAS f32x4*)(out + tok * DM + k0 + 4);
                    a0.x *= rstd * g0.x; a0.y *= rstd * g0.y; a0.z *= rstd * g0.z; a0.w *= rstd * g0.w; a1.x *= rstd * g1.x; a1.y *= rstd * g1.y; a1.z *= rstd * g1.z; a1.w *= rstd * g1.w;
                    v4u hi4, lo4;
                    { const unsigned h0 = f2bf(a0.x), h1 = f2bf(a0.y), h2 = f2bf(a0.z), h3 = f2bf(a0.w), h4 = f2bf(a1.x), h5 = f2bf(a1.y), h6 = f2bf(a1.z), h7 = f2bf(a1.w);
                      hi4.x = h0 | (h1 << 16); hi4.y = h2 | (h3 << 16); hi4.z = h4 | (h5 << 16); hi4.w = h6 | (h7 << 16);
                      lo4.x = pk2(a0.x - bf2f(h0), a0.y - bf2f(h1)); lo4.y = pk2(a0.z - bf2f(h2), a0.w - bf2f(h3)); lo4.z = pk2(a1.x - bf2f(h4), a1.y - bf2f(h5)); lo4.w = pk2(a1.z - bf2f(h6), a1.w - bf2f(h7)); }
                    *(GAS v4u*)(XN + tok * DM + k0) = hi4;
                    ahi[a] = __builtin_bit_cast(bf16x8, hi4); alo[a] = __builtin_bit_cast(bf16x8, lo4); }
#pragma unroll
                for (int n = 0; n < 5; ++n) { const size_t wo = (size_t)(16 * n + (lane & 15)) * 2048 + k0;
                    const bf16x8 bh = *(const bf16x8*)(WRH + wo);
#pragma unroll
                    for (int a = 0; a < 2; ++a) {
                        acc[a][n] = __builtin_amdgcn_mfma_f32_16x16x32_bf16(ahi[a], bh, acc[a][n], 0, 0, 0);
                        acc[a][n] = __builtin_amdgcn_mfma_f32_16x16x32_bf16(alo[a], bh, acc[a][n], 0, 0, 0); } } }
#pragma unroll
            for (int a = 0; a < 2; ++a)
#pragma unroll
                for (int n = 0; n < 5; ++n)
#pragma unroll
                    for (int i = 0; i < 4; ++i) part[(wave * 32 + 16 * a + 4 * (lane >> 4) + i) * 80 + 16 * n + (lane & 15)] = acc[a][n][i];
            __syncthreads();
            for (int e = tid; e < 32 * 80; e += NWAVES * 64) { float a = 0.f;
#pragma unroll
                for (int w = 0; w < 8; ++w) a += part[w * 32 * 80 + e];
                logit[e] = a; }
            __syncthreads();
            if (tid < 32) { const LAS float* lg = logit + tid * 80; const LAS float* bg = rbias; const LAS float* br = rbias + 8;
                float gmax = att::NEG_INF; int gi = 0;
#pragma unroll
                for (int n = 0; n < 8; ++n) { const float v = lg[n] + bg[n]; if (v > gmax) { gmax = v; gi = n; } }
                float gsum = 0.f;
#pragma unroll
                for (int n = 0; n < 8; ++n) gsum += __expf(lg[n] + bg[n] - gmax);
                const float gval = 1.f / gsum;
                float e0 = att::NEG_INF, e1 = att::NEG_INF; int i0 = 0, i1 = 0;
#pragma unroll
                for (int j = 0; j < 8; ++j) { const float v = lg[8 + gi * 8 + j] + br[gi * 8 + j];
                    if (v > e0) { e1 = e0; i1 = i0; e0 = v; i0 = j; } else if (v > e1) { e1 = v; i1 = j; } }
                const float p1 = __expf(e1 - e0), den = 1.f / (1.f + p1);
                const float w0 = gval * den, w1 = gval * p1 * den;
                const int tok = m0 + tid, ex0 = gi * 8 + i0, ex1 = gi * 8 + i1;
                const unsigned q0 = __hip_atomic_fetch_add((unsigned*)(ctl + CW_CNT + ex0), 1u, RLX_AGENT);
                const unsigned q1 = __hip_atomic_fetch_add((unsigned*)(ctl + CW_CNT + ex1), 1u, RLX_AGENT);
                BKT[ex0 * 8192 + q0] = tok; BKTW[ex0 * 8192 + q0] = w0;
                BKT[ex1 * 8192 + q1] = tok | (1 << 16); BKTW[ex1 * 8192 + q1] = w1; }
            __syncthreads();
        }
    }
    GRID_BAR();
    {
        LAS pg8::MoeTile* tiles = (LAS pg8::MoeTile*)(lds + TILES_OFF);
        int tid_t = threadIdx.x; asm volatile("" : "+v"(tid_t));
        if (tid_t < 64) {
            const int e = tid_t; const int c = (int)__hip_atomic_load((unsigned*)(ctl + CW_CNT + e), RLX_AGENT); const int ntl = (c + mg::TM - 1) / mg::TM;
            int pc = c, pt = ntl;
#pragma unroll
            for (int o = 1; o < 64; o <<= 1) { const int a = __shfl_up(pc, o), b = __shfl_up(pt, o); if (e >= o) { pc += a; pt += b; } }
            const int rowbase = pc - c, t0 = pt - ntl;
            for (int mt = 0; mt < ntl; ++mt) if (t0 + mt < 128) { tiles[t0 + mt].e = e; tiles[t0 + mt].mt = mt; tiles[t0 + mt].cnt = c; tiles[t0 + mt].rowbase = rowbase; }
            if (e == 63) MISC[16] = (unsigned)(pt < 128 ? pt : 128); }
        __syncthreads();
        const int ntiles = (int)MISC[16];
        { mg::MoePhase P{(const MLAS mg::MoeTileL*)tiles, ntiles, (const char*)XN, args.in[I_WEG], args.in[I_WEU], BKT, BKTW, HB, YB};
          mg::moe_phase<0>(lds + RING_OFF, P, vcu, G); }
        GRID_BAR();
        { mg::MoePhase P{(const MLAS mg::MoeTileL*)tiles, ntiles, (const char*)HB, args.in[I_WED], nullptr, BKT, BKTW, HB, YB};
          mg::moe_phase<1>(lds + RING_OFF, P, vcu, G); }
    }
    GRID_BAR();
    {
        int tid_ = threadIdx.x; asm volatile("" : "+v"(tid_)); const int lane = tid_ & 63;
        const float* gain = args.in[I_NFIN];
        const bool poison = (__hip_atomic_load(ctl + CW_BAR + XB_TMO, RLX_AGENT) != 0u) || (__hip_atomic_load(ctl + CW_TMO, RLX_AGENT) != 0u);
        f32x4 gv[8];
#pragma unroll
        for (int p = 0; p < 4; ++p) { gv[2 * p] = *(const GAS f32x4*)(gain + 512 * p + 8 * lane); gv[2 * p + 1] = *(const GAS f32x4*)(gain + 512 * p + 8 * lane + 4); }
        f32x4 xv[8]; v4u y0v[4], y1v[4];
        const float* xbase = out;
#define P11_LOAD(m_) do { _Pragma("unroll") for (int p = 0; p < 4; ++p) { const int c0 = 512 * p + 8 * lane; \
            xv[2 * p] = *(const GAS f32x4*)(xbase + (size_t)(m_) * DM + c0); xv[2 * p + 1] = *(const GAS f32x4*)(xbase + (size_t)(m_) * DM + c0 + 4); \
            y0v[p] = *(const GAS v4u*)(YB + (size_t)(m_) * DM + c0); y1v[p] = *(const GAS v4u*)(YB + (size_t)(TOK + (m_)) * DM + c0); } } while (0)
        if (gw < TOK) P11_LOAD(gw);
        for (int m = gw; m < TOK; m += NGW) {
            f32x4 v[8]; float s = 0.f;
#pragma unroll
            for (int p = 0; p < 4; ++p) { v[2 * p] = xv[2 * p]; v[2 * p + 1] = xv[2 * p + 1];
                const v4u y0 = y0v[p], y1 = y1v[p];
                v[2 * p].x += bf2f(y0.x & 0xffffu) + bf2f(y1.x & 0xffffu); v[2 * p].y += bf2f(y0.x >> 16) + bf2f(y1.x >> 16); v[2 * p].z += bf2f(y0.y & 0xffffu) + bf2f(y1.y & 0xffffu); v[2 * p].w += bf2f(y0.y >> 16) + bf2f(y1.y >> 16);
                v[2 * p + 1].x += bf2f(y0.z & 0xffffu) + bf2f(y1.z & 0xffffu); v[2 * p + 1].y += bf2f(y0.z >> 16) + bf2f(y1.z >> 16); v[2 * p + 1].z += bf2f(y0.w & 0xffffu) + bf2f(y1.w & 0xffffu); v[2 * p + 1].w += bf2f(y0.w >> 16) + bf2f(y1.w >> 16);
            }
            if (m + NGW < TOK) P11_LOAD(m + NGW);
#pragma unroll
            for (int j = 0; j < 8; ++j) s += (v[j].x * v[j].x + v[j].y * v[j].y) + (v[j].z * v[j].z + v[j].w * v[j].w);
            const float rstd = 1.f / sqrtf(wave_sum(s) * (1.f / DM) + RMS_EPS);
#pragma unroll
            for (int p = 0; p < 4; ++p) { const int c0 = 512 * p + 8 * lane;
#pragma unroll
                for (int q = 0; q < 2; ++q) { const f32x4 g = gv[2 * p + q]; const f32x4 w = v[2 * p + q]; f32x4 y; y.x = w.x * rstd * g.x; y.y = w.y * rstd * g.y; y.z = w.z * rstd * g.z; y.w = w.w * rstd * g.w;
                    if (poison) { const float qn = __builtin_nanf(""); y.x = qn; y.y = qn; y.z = qn; y.w = qn; }
                    *(GAS f32x4*)(out + (size_t)m * DM + c0 + 4 * q) = y; } }
        }
#undef P11_LOAD
    }
#undef GRID_BAR
}

extern "C" void kernel_launch(void* const* d_in, const int* in_sizes, int n_in, void* d_out, int out_size, void* d_ws, size_t ws_size, hipStream_t stream) {
    static int grid = 0;
    if (grid == 0) {
        if (n_in != 22 || in_sizes[0] != TOK * DM || out_size != TOK * DM || ws_size < WS_END) {
            fprintf(stderr, "kernel_launch: unexpected problem (n_in %d, in0 %d, out %d, ws %zu < %zu?); nothing launched\n", n_in, n_in > 0 ? in_sizes[0] : -1, out_size, ws_size, (size_t)WS_END); grid = -1; return; }
        int dev = 0, cus = 0, per_cu = 0;
        if (hipGetDevice(&dev) != hipSuccess || hipDeviceGetAttribute(&cus, hipDeviceAttributeMultiprocessorCount, dev) != hipSuccess) { fprintf(stderr, "kernel_launch: device query failed\n"); grid = -1; return; }
        if (hipFuncSetAttribute((const void*)fwd_kernel, hipFuncAttributeMaxDynamicSharedMemorySize, LDS_BYTES) != hipSuccess) { fprintf(stderr, "kernel_launch: hipFuncSetAttribute failed\n"); grid = -1; return; }
        if (hipOccupancyMaxActiveBlocksPerMultiprocessor(&per_cu, (const void*)fwd_kernel, NWAVES * 64, LDS_BYTES) != hipSuccess || per_cu < 1)
            fprintf(stderr, "kernel_launch: note: occupancy query reports %d workgroups per CU\n", per_cu);
        (void)hipGetLastError();
        grid = cus;
    }
    if (grid < 0) return;
    if (hipMemsetAsync((char*)d_ws + WS_CTL, 0, CTL_ZERO_BYTES, stream) != hipSuccess) { fprintf(stderr, "kernel_launch: memset failed\n"); return; }
    Args a{};
    for (int i = 0; i < 22; ++i) a.in[i] = (const float*)d_in[i];
    a.out = (float*)d_out; a.ws = (unsigned char*)d_ws;
    hipLaunchKernelGGL(fwd_kernel, dim3(grid), dim3(NWAVES * 64), LDS_BYTES, stream, a);
    const hipError_t le = hipPeekAtLastError();
    if (le != hipSuccess) fprintf(stderr, "kernel_launch: launch failed: %s\n", hipGetErrorName(le));
}
```

```cpp
#include <hip/hip_runtime.h>
#include <cstdio>
#include <cstdint>
template <int X> __device__ __forceinline__ float quad_xor(float v) {
    constexpr int ctrl = X == 1 ? 0xB1 : X == 2 ? 0x4E : 0x1B;
    const int i = __builtin_bit_cast(int, v);
    return __builtin_bit_cast(float, __builtin_amdgcn_update_dpp(i, i, ctrl, 0xF, 0xF, true));
}
namespace pg8 {
#define PG8_LAS __attribute__((address_space(3)))
typedef unsigned short bf16_t;
typedef short bf16x8 __attribute__((ext_vector_type(8)));
typedef float f32x4 __attribute__((ext_vector_type(4)));
typedef unsigned u32x4 __attribute__((ext_vector_type(4)));
constexpr int BM = 256, BK = 64, HALF = 128, HTB = HALF * BK * 2  , STAGE_BYTES = 8 * HTB, NXCD = 8, WGM = 8;

__host__ __device__ __forceinline__ int lds_byte(int r, int c) { const int st = (r >> 4) * 2 + (c >> 5), rr = r & 15, cc = c & 31, ob = rr * 64 + cc * 2; return st * 1024 + (ob ^ (((ob >> 9) & 1) << 5)); }
__host__ __device__ __forceinline__ void stage_rc(int b, int& R, int& C) { const int st = b / 1024, sb = b % 1024, swz = sb ^ (((sb >> 9) & 1) << 5); R = (st >> 1) * 16 + swz / 64; C = (st & 1) * 32 + (swz % 64) / 2; }
__host__ __device__ __forceinline__ int perm32(int rho) { const int n = rho >> 4, i = rho & 15; return 8 * (i >> 2) + 4 * n + (i & 3); }

struct Unit { int pm, pn; const char* A; const char* B; int x0, x1, x2; };

struct StaticOrder {
    int nM, nN, nwg, G, c; const char* A; const char* Bt; size_t tstep;
    __device__ void init(const void* A_, const void* Bt_, int M, int N, int K, int G_, int c_) { nM = M / BM; nN = N / BM; nwg = nM * nN; G = G_; c = c_; A = (const char*)A_; Bt = (const char*)Bt_; tstep = (size_t)BM * K * 2; }
    __device__ bool next(int i, Unit& u) const {
        const long L = (long)i * G + c; if (c < 0 || L >= nwg) return false;
        int wgid = (int)L; { const int q = nwg / NXCD, r = nwg % NXCD, xcd = wgid % NXCD, off = wgid / NXCD; wgid = (xcd < r ? xcd * (q + 1) : r * (q + 1) + (xcd - r) * q) + off; }
        const int nig = WGM * nN, gid = wgid / nig, fm = gid * WGM, gsz = (nM - fm) < WGM ? (nM - fm) : WGM;
        u.pm = fm + ((wgid % nig) % gsz); u.pn = (wgid % nig) / gsz; u.A = A + (size_t)u.pm * tstep; u.B = Bt + (size_t)u.pn * tstep; u.x0 = u.x1 = u.x2 = 0; return true;
    }
    __device__ __forceinline__ void a_ready(const Unit&) const {}
    __device__ __forceinline__ void done(const Unit&) const {}
    __device__ __forceinline__ void gather(const Unit&, unsigned (&)[2][2], int) const {}
};

typedef float f32x2_cv __attribute__((ext_vector_type(2))); typedef __bf16 bf16x2_cv __attribute__((ext_vector_type(2)));
__device__ __forceinline__ unsigned cvt_pk_bf16(float lo, float hi) { f32x2_cv v = {lo, hi}; bf16x2_cv b = __builtin_convertvector(v, bf16x2_cv); return __builtin_bit_cast(unsigned, b); }

template <class Epi, class Sched, bool ALIGN_EPI, bool GATHER, bool FP8 = false, int SCA = 127>
__device__ __forceinline__ void gemm_phase(PG8_LAS unsigned char* lds, const int K, const Sched& S, const Epi& E, const int LD = 0) {
    int tid = threadIdx.x; asm volatile("" : "+v"(tid));
    const int wid = __builtin_amdgcn_readfirstlane(tid >> 6), lane = tid & 63, wr = wid >> 2, wc = wid & 3, fr = lane & 15, fq = lane >> 4;
    const int nt = K / BK, ld = LD ? LD : K;
    unsigned voC[2][2], voN[2][2], voffB[2];
    const size_t kstep = (size_t)(BK * 2);
    const size_t hstep = (size_t)HALF * ld * 2;
#pragma unroll
    for (int i = 0; i < 2; ++i) { int R, C; stage_rc(tid * 16 + i * 8192, R, C); const int Rb = Epi::PERM ? ((R & ~31) + perm32(R & 31)) : R;
        voC[0][i] = (unsigned)(R * ld + C) * 2u; voC[1][i] = voC[0][i] + (unsigned)hstep; voffB[i] = (unsigned)(Rb * ld + C) * 2u; }
    const unsigned ldsw = (unsigned)wid * 1024u;
    const int aoff = lds_byte(wr * 64 + fr, fq * 8), boff = lds_byte(wc * 32 + fr, fq * 8);
#define PG8_SA(b, h) (((b) * 2 + (h)) * HTB)
#define PG8_SB(b, h) ((4 + (b) * 2 + (h)) * HTB)
#define PG8_STAGE(bufoff, gbase, voff) do { _Pragma("unroll") for (int _i = 0; _i < 2; ++_i) \
        __builtin_amdgcn_global_load_lds((const unsigned*)((const char*)(gbase) + (voff)[_i]), (PG8_LAS unsigned*)(lds + (bufoff) + ldsw + _i * 8192), 16, 0, 0); } while (0)
    typedef int v8i_ __attribute__((ext_vector_type(8))); typedef int v4i_ __attribute__((ext_vector_type(4)));
#define PG8_LDA(dst, b, h) do { _Pragma("unroll") for (int m = 0; m < 4; ++m) { const v4i_ lo_ = *(const PG8_LAS v4i_*)(lds + PG8_SA(b, h) + aoff + m * 2048), hi_ = *(const PG8_LAS v4i_*)(lds + PG8_SA(b, h) + aoff + m * 2048 + 1024); \
        dst[m] = __builtin_shufflevector(lo_, hi_, 0, 1, 2, 3, 4, 5, 6, 7); } } while (0)
#define PG8_LDB(dst, b, h) do { _Pragma("unroll") for (int n = 0; n < 2; ++n) { const v4i_ lo_ = *(const PG8_LAS v4i_*)(lds + PG8_SB(b, h) + boff + n * 2048), hi_ = *(const PG8_LAS v4i_*)(lds + PG8_SB(b, h) + boff + n * 2048 + 1024); \
        dst[n] = __builtin_shufflevector(lo_, hi_, 0, 1, 2, 3, 4, 5, 6, 7); } } while (0)
#define PG8_MMA(ai, bj, At, Bt) do { __builtin_amdgcn_s_setprio(1); _Pragma("unroll") for (int m = 0; m < 4; ++m) _Pragma("unroll") for (int n = 0; n < 2; ++n) { \
        if constexpr (FP8) { acc[ai][bj][m][n] = __builtin_amdgcn_mfma_scale_f32_16x16x128_f8f6f4(Bt[n], At[m], acc[ai][bj][m][n], 0, 0, 0, 121, 0, SCA); } \
        else { acc[ai][bj][m][n] = __builtin_amdgcn_mfma_f32_16x16x32_bf16(__builtin_bit_cast(bf16x8, __builtin_shufflevector(Bt[n], Bt[n], 0, 1, 2, 3)), __builtin_bit_cast(bf16x8, __builtin_shufflevector(At[m], At[m], 0, 1, 2, 3)), acc[ai][bj][m][n], 0, 0, 0); \
               acc[ai][bj][m][n] = __builtin_amdgcn_mfma_f32_16x16x32_bf16(__builtin_bit_cast(bf16x8, __builtin_shufflevector(Bt[n], Bt[n], 4, 5, 6, 7)), __builtin_bit_cast(bf16x8, __builtin_shufflevector(At[m], At[m], 4, 5, 6, 7)), acc[ai][bj][m][n], 0, 0, 0); } } \
        __builtin_amdgcn_s_setprio(0); } while (0)
#define PG8_WAIT_V(n) asm volatile("s_waitcnt vmcnt(" #n ")" ::: "memory")
#define PG8_WAIT_L(n) asm volatile("s_waitcnt lgkmcnt(" #n ")" ::: "memory")
#define PG8_BAR __builtin_amdgcn_s_barrier()
#define PG8_SCHED __builtin_amdgcn_sched_barrier(0)
    Unit cur, nxt; int ui = 0;
    if (!S.next(0, cur)) return;
    f32x4 acc[2][2][4][2];
#pragma unroll
    for (int a = 0; a < 2; ++a)
#pragma unroll
        for (int b = 0; b < 2; ++b)
#pragma unroll
            for (int m = 0; m < 4; ++m)
#pragma unroll
                for (int n = 0; n < 2; ++n) acc[a][b][m][n] = (f32x4){0.f, 0.f, 0.f, 0.f};
    v8i_ At[4], B0[2], B1[2];
    const char* cA = cur.A; const char* cB = cur.B;
    S.a_ready(cur);
    if constexpr (GATHER) { S.gather(cur, voC, tid); }
#pragma unroll
    for (int h = 0; h < 2; ++h)
#pragma unroll
        for (int i = 0; i < 2; ++i) voN[h][i] = voC[h][i];
    PG8_STAGE(PG8_SB(0, 0), cB, voffB); PG8_STAGE(PG8_SB(0, 1), cB + hstep, voffB); PG8_STAGE(PG8_SA(0, 0), cA, voC[0]); PG8_STAGE(PG8_SA(0, 1), cA, voC[1]);
    if (wr == 1) PG8_BAR;
    PG8_WAIT_V(2); PG8_BAR;
    PG8_STAGE(PG8_SB(1, 0), cB + kstep, voffB); PG8_STAGE(PG8_SA(1, 0), cA + kstep, voC[0]); PG8_STAGE(PG8_SB(1, 1), cB + hstep + kstep, voffB);
    PG8_WAIT_V(6); PG8_BAR;
    for (;;) {
        const bool has_next = S.next(ui + 1, nxt);
        const char* nA = has_next ? nxt.A : cA; const char* nB = has_next ? nxt.B : cB;
        for (int t = 0; t < nt; t += 2) {
            const bool last = (t == nt - 2);
            const char* a1 = cA + (size_t)(t + 1) * kstep;
            const char* a2 = last ? nA : cA + (size_t)(t + 2) * kstep; const char* b2 = last ? nB : cB + (size_t)(t + 2) * kstep;
            const char* a3 = a2 + kstep; const char* b3 = b2 + kstep;
            if constexpr (FP8) { asm volatile("" : "+s"(a1), "+s"(a2), "+s"(a3), "+s"(b2), "+s"(b3)); }
            if (last && has_next) { S.a_ready(nxt); if constexpr (GATHER) { S.gather(nxt, voN, tid); } }
            unsigned v2[2][2];
#pragma unroll
            for (int h = 0; h < 2; ++h)
#pragma unroll
                for (int i = 0; i < 2; ++i) v2[h][i] = (GATHER && last) ? voN[h][i] : voC[h][i];
            if constexpr (FP8) {
#define PG8_LDA2(dst, b, h, m0) do { _Pragma("unroll") for (int m = 0; m < 2; ++m) { const v4i_ lo_ = *(const PG8_LAS v4i_*)(lds + PG8_SA(b, h) + aoff + ((m0) + m) * 2048), hi_ = *(const PG8_LAS v4i_*)(lds + PG8_SA(b, h) + aoff + ((m0) + m) * 2048 + 1024); \
        dst[m] = __builtin_shufflevector(lo_, hi_, 0, 1, 2, 3, 4, 5, 6, 7); } } while (0)
#define PG8_MMA2(ai, bj, At, Bt, m0) do { _Pragma("unroll") for (int m = 0; m < 2; ++m) _Pragma("unroll") for (int n = 0; n < 2; ++n) \
        acc[ai][bj][(m0) + m][n] = __builtin_amdgcn_mfma_scale_f32_16x16x128_f8f6f4(Bt[n], At[m], acc[ai][bj][(m0) + m][n], 0, 0, 0, 121, 0, SCA); } while (0)
#define PG8_SUPER(ai, b, h) do { __builtin_amdgcn_s_setprio(1); PG8_MMA2(ai, 0, At, B0, 0); PG8_MMA2(ai, 1, At, B1, 0); PG8_LDA2(At, b, h, 2); PG8_MMA2(ai, 0, At, B0, 2); PG8_MMA2(ai, 1, At, B1, 2); __builtin_amdgcn_s_setprio(0); } while (0)
            PG8_LDB(B0, 0, 0); PG8_LDB(B1, 0, 1); PG8_SCHED; PG8_LDA2(At, 0, 0, 0); PG8_STAGE(PG8_SA(1, 1), a1, voC[1]);
            PG8_WAIT_V(8); PG8_WAIT_L(0); PG8_BAR; PG8_SUPER(0, 0, 0); PG8_BAR; PG8_SCHED;
            PG8_LDA2(At, 0, 1, 0); PG8_STAGE(PG8_SB(0, 0), b2, voffB); PG8_STAGE(PG8_SB(0, 1), b2 + hstep, voffB); PG8_STAGE(PG8_SA(0, 0), a2, v2[0]);
            PG8_WAIT_V(8); PG8_WAIT_L(0); PG8_BAR; PG8_SUPER(1, 0, 1); PG8_BAR; PG8_SCHED;
            PG8_LDB(B0, 1, 0); PG8_LDB(B1, 1, 1); PG8_SCHED; PG8_LDA2(At, 1, 0, 0); PG8_STAGE(PG8_SA(0, 1), a2, v2[1]);
            PG8_WAIT_V(8); PG8_WAIT_L(0); PG8_BAR; PG8_SUPER(0, 1, 0); PG8_BAR; PG8_SCHED;
            PG8_LDA2(At, 1, 1, 0); PG8_STAGE(PG8_SB(1, 0), b3, voffB); PG8_STAGE(PG8_SB(1, 1), b3 + hstep, voffB); PG8_STAGE(PG8_SA(1, 0), a3, v2[0]);
            PG8_WAIT_V(8); PG8_WAIT_L(0); PG8_BAR; PG8_SUPER(1, 1, 1); PG8_BAR; PG8_SCHED;
#undef PG8_SUPER
#undef PG8_MMA2
#undef PG8_LDA2
            } else {
            PG8_LDB(B0, 0, 0); PG8_LDB(B1, 0, 1); PG8_SCHED; PG8_LDA(At, 0, 0); PG8_STAGE(PG8_SA(1, 1), a1, voC[1]);
            PG8_WAIT_V(8); PG8_WAIT_L(0); PG8_BAR; PG8_MMA(0, 0, At, B0); PG8_MMA(0, 1, At, B1); PG8_BAR; PG8_SCHED;
            PG8_LDA(At, 0, 1); PG8_STAGE(PG8_SB(0, 0), b2, voffB); PG8_STAGE(PG8_SB(0, 1), b2 + hstep, voffB); PG8_STAGE(PG8_SA(0, 0), a2, v2[0]);
            PG8_WAIT_V(8); PG8_WAIT_L(0); PG8_BAR; PG8_MMA(1, 0, At, B0); PG8_MMA(1, 1, At, B1); PG8_BAR; PG8_SCHED;
            PG8_LDB(B0, 1, 0); PG8_LDB(B1, 1, 1); PG8_SCHED; PG8_LDA(At, 1, 0); PG8_STAGE(PG8_SA(0, 1), a2, v2[1]);
            PG8_WAIT_V(8); PG8_WAIT_L(0); PG8_BAR; PG8_MMA(0, 0, At, B0); PG8_MMA(0, 1, At, B1); PG8_BAR; PG8_SCHED;
            PG8_LDA(At, 1, 1); PG8_STAGE(PG8_SB(1, 0), b3, voffB); PG8_STAGE(PG8_SB(1, 1), b3 + hstep, voffB); PG8_STAGE(PG8_SA(1, 0), a3, v2[0]);
            PG8_WAIT_V(8); PG8_WAIT_L(0); PG8_BAR; PG8_MMA(1, 0, At, B0); PG8_MMA(1, 1, At, B1); PG8_BAR; PG8_SCHED;
            }
        }
        if constexpr (ALIGN_EPI) { if (wr == 0) PG8_BAR; }
        E(acc, cur, wr, wc, fr, fq); S.done(cur);
        if (!has_next) break;
#pragma unroll
        for (int a = 0; a < 2; ++a)
#pragma unroll
            for (int b = 0; b < 2; ++b)
#pragma unroll
                for (int m = 0; m < 4; ++m)
#pragma unroll
                    for (int n = 0; n < 2; ++n) acc[a][b][m][n] = (f32x4){0.f, 0.f, 0.f, 0.f};
        cur = nxt; cA = nA; cB = nB; ++ui;
        if constexpr (GATHER) {
#pragma unroll
            for (int h = 0; h < 2; ++h)
#pragma unroll
                for (int i = 0; i < 2; ++i) voC[h][i] = voN[h][i];
        }
        if constexpr (ALIGN_EPI) { if (wr == 1) PG8_BAR; }
    }
    PG8_WAIT_V(0);
    if constexpr (!ALIGN_EPI) { if (wr == 0) PG8_BAR; }
    PG8_BAR;
#undef PG8_SA
#undef PG8_SB
#undef PG8_STAGE
#undef PG8_LDA
#undef PG8_LDB
#undef PG8_MMA
#undef PG8_WAIT_V
#undef PG8_WAIT_L
#undef PG8_BAR
#undef PG8_SCHED
}
}
namespace pg8 {
__device__ __forceinline__ float sigmoidf_fast(float x) { return __builtin_amdgcn_rcpf(1.0f + __builtin_amdgcn_exp2f(-1.4426950408889634f * x)); }
__device__ __forceinline__ float bf_lo(unsigned w) { return __uint_as_float(w << 16); }
__device__ __forceinline__ float bf_hi(unsigned w) { return __uint_as_float(w & 0xffff0000u); }

struct EpiProj {
    static constexpr bool PERM = true;
    bf16_t* QA; bf16_t* KV6; bf16_t* QKVB; bf16_t* GM; float* GATE;
    __device__ __forceinline__ void operator()(const f32x4 (&acc)[2][2][4][2], const Unit& u, int wr, int wc, int fr, int fq) const {
        const int row0 = u.pm * BM + wr * 64 + fr, pn = u.pn;
        if (pn < 22) {
            bf16_t* base; int nh, hd0;
            if (pn < 4) { base = QA; nh = 8; hd0 = 2 * pn; }
            else if (pn < 10) { base = KV6 + (size_t)(pn - 4) * 2097152u; nh = 2; hd0 = 0; }
            else { base = QKVB + (size_t)((pn - 10) >> 2) * 8388608u; nh = 8; hd0 = 2 * ((pn - 10) & 3); }
#pragma unroll
            for (int ai = 0; ai < 2; ++ai)
#pragma unroll
                for (int m = 0; m < 4; ++m) { const int row = row0 + ai * HALF + m * 16, b = row >> 12, t = row & 4095;
#pragma unroll
                    for (int bj = 0; bj < 2; ++bj) { const f32x4 v0 = acc[ai][bj][m][0], v1 = acc[ai][bj][m][1];
                        u32x4 w; w.x = cvt_pk_bf16(v0[0], v0[1]); w.y = cvt_pk_bf16(v0[2], v0[3]); w.z = cvt_pk_bf16(v1[0], v1[1]); w.w = cvt_pk_bf16(v1[2], v1[3]);
                        *(u32x4*)(base + ((size_t)((b * nh + hd0 + bj) * 4096 + t) * 128 + wc * 32 + 8 * fq)) = w; } }
        } else if (pn < 38) {
            int fq_ = fq, fr_ = fr; asm volatile("" : "+v"(fq_), "+v"(fr_)); const int row0 = u.pm * BM + wr * 64 + fr_;
            bf16_t* base = GM + (size_t)((pn - 22) >> 3) * 16777216u; const int col0 = ((pn - 22) & 7) * 256 + wc * 32 + 8 * fq_;
#pragma unroll
            for (int ai = 0; ai < 2; ++ai)
#pragma unroll
                for (int m = 0; m < 4; ++m) { bf16_t* rowp = base + (size_t)(row0 + ai * HALF + m * 16) * 2048 + col0;
#pragma unroll
                    for (int bj = 0; bj < 2; ++bj) { f32x4 v0 = acc[ai][bj][m][0], v1 = acc[ai][bj][m][1];
#pragma unroll
                        for (int j = 0; j < 4; ++j) { v0[j] = sigmoidf_fast(v0[j]); v1[j] = sigmoidf_fast(v1[j]); }
                        u32x4 w; w.x = cvt_pk_bf16(v0[0], v0[1]); w.y = cvt_pk_bf16(v0[2], v0[3]); w.z = cvt_pk_bf16(v1[0], v1[1]); w.w = cvt_pk_bf16(v1[2], v1[3]);
                        *(u32x4*)(rowp + bj * HALF) = w; } }
        } else {
            if (wc == 0) {
                int fq_ = fq, fr_ = fr; asm volatile("" : "+v"(fq_), "+v"(fr_));
                const int row0g = u.pm * BM + wr * 64 + fr_;
#pragma unroll
                for (int ai = 0; ai < 2; ++ai)
#pragma unroll
                    for (int m = 0; m < 4; ++m) { float* rowp = GATE + (size_t)(row0g + ai * HALF + m * 16) * 32 + 8 * fq_;
                        f32x4 v0 = acc[ai][0][m][0], v1 = acc[ai][0][m][1];
#pragma unroll
                        for (int j = 0; j < 4; ++j) { v0[j] = sigmoidf_fast(v0[j]); v1[j] = sigmoidf_fast(v1[j]); }
                        *(f32x4*)rowp = v0; *(f32x4*)(rowp + 4) = v1; }
            }
        }
    }
};

struct EpiF32 {
    static constexpr bool PERM = false;
    float* C; int ldc; const float* resid; float* SS;
    __device__ __forceinline__ void operator()(const f32x4 (&acc)[2][2][4][2], const Unit& u, int wr, int wc, int fr, int fq) const {
        const int row0 = u.pm * BM + wr * 64 + fr, col0 = u.pn * BM + wc * 32 + 4 * fq;
        f32x4 rv[2][4];
#define EF_LOAD(slot, g_) do { const size_t off_ = (size_t)(row0 + ((g_) >> 2) * HALF + ((g_) & 3) * 16) * ldc + col0; \
        _Pragma("unroll") for (int q = 0; q < 4; ++q) rv[slot][q] = resid ? *(const f32x4*)(resid + off_ + (q >> 1) * HALF + (q & 1) * 16) : (f32x4){0.f, 0.f, 0.f, 0.f}; } while (0)
        EF_LOAD(0, 0);
#pragma unroll
        for (int g = 0; g < 8; ++g) { const int ai = g >> 2, m = g & 3; const size_t off = (size_t)(row0 + ai * HALF + m * 16) * ldc + col0;
            if (g + 1 < 8) EF_LOAD((g + 1) & 1, g + 1);
            float ss = 0.f;
#pragma unroll
            for (int q = 0; q < 4; ++q) { const int bj = q >> 1, n = q & 1; const f32x4 v = acc[ai][bj][m][n] + rv[g & 1][q]; *(f32x4*)(C + off + bj * HALF + n * 16) = v;
                ss += (v[0] * v[0] + v[1] * v[1]) + (v[2] * v[2] + v[3] * v[3]); }
            if (SS) { ss += __shfl_xor(ss, 16); ss += __shfl_xor(ss, 32); if (fq == 0) SS[(size_t)(4 * u.pn + wc) * 8192 + row0 + ai * HALF + m * 16] = ss; } }
#undef EF_LOAD
    }
};

struct SplitKOrder {
    const char* A0; const char* B0k; const char* B0v; int c;
    __device__ bool next(int i, Unit& u) const {
        if (i != 0 || c < 0 || c >= 128) return false;
        const int ks = c & 7, pn = (c >> 3) & 1, pm = (c >> 4) & 3, kv = c >> 6;
        u.pm = pm; u.pn = pn; u.x0 = (kv * 8 + ks) * 1024 * 512; u.x1 = u.x2 = 0;
        u.A = A0 + ((size_t)kv * 2097152u + (size_t)pm * 256 * 2048 + ks * 256) * 2; u.B = (kv ? B0v : B0k) + ((size_t)pn * 256 * 2048 + ks * 256) * 2; return true;
    }
    __device__ __forceinline__ void a_ready(const Unit&) const {}
    __device__ __forceinline__ void done(const Unit&) const {}
    __device__ __forceinline__ void gather(const Unit&, unsigned (&)[2][2], int) const {}
};
struct EpiF32Split {
    static constexpr bool PERM = false;
    float* C;
    __device__ __forceinline__ void operator()(const f32x4 (&acc)[2][2][4][2], const Unit& u, int wr, int wc, int fr, int fq) const {
        const int row0 = u.pm * BM + wr * 64 + fr, col0 = u.pn * BM + wc * 32 + 4 * fq;
#pragma unroll
        for (int ai = 0; ai < 2; ++ai)
#pragma unroll
            for (int m = 0; m < 4; ++m) { float* rp = C + (size_t)u.x0 + (size_t)(row0 + ai * HALF + m * 16) * 512 + col0;
#pragma unroll
                for (int bj = 0; bj < 2; ++bj)
#pragma unroll
                    for (int n = 0; n < 2; ++n) *(f32x4*)(rp + bj * HALF + n * 16) = acc[ai][bj][m][n]; }
    }
};

template <bool ADD, bool PIPE = true> struct EpiGated {
    static constexpr bool PERM = true;
    bf16_t* O; const bf16_t* G; unsigned char* O8;
    __device__ __forceinline__ void operator()(const f32x4 (&acc)[2][2][4][2], const Unit& u, int wr, int wc, int fr, int fq) const {
        int fq_ = fq, fr_ = fr; if (!PIPE) asm volatile("" : "+v"(fq_), "+v"(fr_));
        const int row0 = u.pm * BM + wr * 64 + fr_, col0 = u.pn * BM + wc * 32 + 8 * fq_;
        u32x4 gv[2][2], ov[2][2];
#define EG_LOAD(slot, g_) do { const size_t off_ = (size_t)(row0 + ((g_) >> 2) * HALF + ((g_) & 3) * 16) * 2048 + col0; \
        _Pragma("unroll") for (int bj = 0; bj < 2; ++bj) { gv[slot][bj] = *(const u32x4*)(G + off_ + bj * HALF); if (ADD) ov[slot][bj] = *(const u32x4*)(O + off_ + bj * HALF); } } while (0)
        if (PIPE) EG_LOAD(0, 0);
#pragma unroll
        for (int gi = 0; gi < 8; ++gi) { const int ai = gi >> 2, m = gi & 3; const size_t off = (size_t)(row0 + ai * HALF + m * 16) * 2048 + col0;
            if (PIPE) { if (gi + 1 < 8) EG_LOAD((gi + 1) & 1, gi + 1); } else EG_LOAD(gi & 1, gi);
#pragma unroll
            for (int bj = 0; bj < 2; ++bj) { const u32x4 g = gv[gi & 1][bj]; f32x4 v0 = acc[ai][bj][m][0], v1 = acc[ai][bj][m][1];
                v0[0] *= bf_lo(g.x); v0[1] *= bf_hi(g.x); v0[2] *= bf_lo(g.y); v0[3] *= bf_hi(g.y); v1[0] *= bf_lo(g.z); v1[1] *= bf_hi(g.z); v1[2] *= bf_lo(g.w); v1[3] *= bf_hi(g.w);
                if (ADD) { const u32x4 o = ov[gi & 1][bj];
                    v0[0] += bf_lo(o.x); v0[1] += bf_hi(o.x); v0[2] += bf_lo(o.y); v0[3] += bf_hi(o.y); v1[0] += bf_lo(o.z); v1[1] += bf_hi(o.z); v1[2] += bf_lo(o.w); v1[3] += bf_hi(o.w); }
                if (ADD && O8) { int q0 = __builtin_amdgcn_cvt_pk_fp8_f32(v0[0], v0[1], 0, false); q0 = __builtin_amdgcn_cvt_pk_fp8_f32(v0[2], v0[3], q0, true); int q1 = __builtin_amdgcn_cvt_pk_fp8_f32(v1[0], v1[1], 0, false); q1 = __builtin_amdgcn_cvt_pk_fp8_f32(v1[2], v1[3], q1, true);
                    typedef unsigned u32x2_ __attribute__((ext_vector_type(2))); u32x2_ q; q.x = (unsigned)q0; q.y = (unsigned)q1; *(u32x2_*)(O8 + off + bj * HALF) = q; }
                else { u32x4 w; w.x = cvt_pk_bf16(v0[0], v0[1]); w.y = cvt_pk_bf16(v0[2], v0[3]); w.z = cvt_pk_bf16(v1[0], v1[1]); w.w = cvt_pk_bf16(v1[2], v1[3]);
                    *(u32x4*)(O + off + bj * HALF) = w; } } }
#undef EG_LOAD
    }
};

struct MoeTile { int e, mt, cnt, rowbase; };
}
namespace mg {
#define MLAS __attribute__((address_space(3)))
typedef short bf16x8 __attribute__((ext_vector_type(8)));
typedef short s16x4 __attribute__((ext_vector_type(4)));
typedef float f32x16 __attribute__((ext_vector_type(16)));
typedef float f32x4 __attribute__((ext_vector_type(4)));
typedef unsigned u32x4 __attribute__((ext_vector_type(4)));
typedef unsigned u32x2 __attribute__((ext_vector_type(2)));
typedef short v4i16_t __attribute__((ext_vector_type(4)));
constexpr int TM = 384, LA = 0, A_BYTES = TM * 128, LB = 2 * A_BYTES, B_BYTES = 16384, LT = LB + 2 * B_BYTES;
__device__ __forceinline__ unsigned off_b(unsigned row, unsigned ch) { return 256u * row + 16u * (ch ^ (((row & 3u) << 2) | ((row >> 2) & 3u))); }
__device__ __forceinline__ unsigned tr_read_addr(unsigned lane, unsigned c, unsigned t) {
    const unsigned h = lane >> 5, blk = (lane >> 4) & 1, q = (lane & 15) >> 2, p = lane & 3;
    return off_b(8 * h + 4 * t + q, 4 * c + 2 * blk + (p >> 1)) + 8 * (p & 1);
}
__device__ __forceinline__ s16x4 vtr(const MLAS char* p) { return __builtin_bit_cast(s16x4, __builtin_amdgcn_ds_read_tr16_b64_v4i16((MLAS v4i16_t*)p)); }
__device__ __forceinline__ unsigned cvt2(float lo, float hi) { typedef float f2 __attribute__((ext_vector_type(2))); typedef __bf16 b2 __attribute__((ext_vector_type(2))); f2 v = {lo, hi}; b2 b = __builtin_convertvector(v, b2); return __builtin_bit_cast(unsigned, b); }

struct MoeJob { int e, mt, cnt, rowbase, ns; };
struct MoeTileL { int e, mt, cnt, rowbase; };
struct MoePhase {
    const MLAS MoeTileL* tiles; int ntiles;
    const char* Abase;
    const float* W0; const float* W1;
    const int* bucket; const float* bucket_w;
    unsigned short* H; unsigned short* Y;
};

template <int MODE>
__device__ __forceinline__ void moe_phase(MLAS unsigned char* lds, const MoePhase& P, int c, int G) {
    constexpr int K = MODE == 0 ? 2048 : 512, NT = K / 64, LDN = MODE == 0 ? 512 : 2048, AROW = K * 2, NSL = MODE == 0 ? 8 : 16;
    int tid = threadIdx.x; asm volatile("" : "+v"(tid));
    const int wave = __builtin_amdgcn_readfirstlane(tid >> 6), lane = tid & 63, r32 = lane & 31, hi = lane >> 5, wm = wave & 3, wn = wave >> 2;
    MLAS char* Al = (MLAS char*)lds + LA; MLAS char* Bl = (MLAS char*)lds + LB;
    const int total = P.ntiles * NSL;
    int L = c; if (L >= total) return;
    const int ach = tid & 7, c4 = tid & 31, kr = tid >> 5;
    unsigned arow[3]; unsigned avalid = 0u;
    const float* bp = nullptr;
    const unsigned awr0 = (unsigned)(tid >> 3) * 128u + (((unsigned)ach ^ ((unsigned)(tid >> 4) & 7u)) << 4);
    const unsigned aoff0 = (unsigned)(wm * 96 + r32) * 128u + ((((unsigned)hi) ^ (((unsigned)(wm * 96 + r32) >> 1) & 7u)) << 4);
    const unsigned boff00 = tr_read_addr((unsigned)lane, (unsigned)wn, 0u);
#define MG_AOFF(s) (aoff0 ^ ((unsigned)(s) << 5))
#define MG_BOFF(j, t) ((boff00 ^ (128u * (j)) ^ (16u * (t))) + 1024u * (t))
    u32x4 sa0[6] = {}, sb0[4] = {}, sa1[6] = {}, sb1[4] = {};
    int koff = 0;
    MoeJob J; int ui = 0;
    MLAS int* tabE = (MLAS int*)(lds + LT); MLAS float* tabW = (MLAS float*)(lds + LT + 4096);
#define MG_JOB(Lx) do { const int ti_ = (Lx) / NSL; J.e = P.tiles[ti_].e; J.mt = P.tiles[ti_].mt; J.cnt = P.tiles[ti_].cnt; J.rowbase = P.tiles[ti_].rowbase; J.ns = (Lx) % NSL; } while (0)
#define MG_SETUP() do { koff = (J.e * 5 + J.mt * 3) & (NT - 1); int tid_s = threadIdx.x; asm volatile("" : "+v"(tid_s)); avalid = 0u;     unsigned ent_[6] = {0u, 0u, 0u, 0u, 0u, 0u}; \
        if (MODE == 0) { _Pragma("unroll") for (int i = 0; i < 6; ++i) { const int idx = J.mt * TM + (tid_s >> 3) + 64 * i; ent_[i] = (unsigned)P.bucket[J.e * 8192 + (idx < J.cnt ? idx : 0)]; } \
            asm volatile("" : "+v"(ent_[0]), "+v"(ent_[1]), "+v"(ent_[2]), "+v"(ent_[3]), "+v"(ent_[4]), "+v"(ent_[5])); }     \
        _Pragma("unroll") for (int i = 0; i < 6; ++i) { const int idx = J.mt * TM + (tid_s >> 3) + 64 * i; unsigned rowoff = 0u; \
            if (idx < J.cnt) { avalid |= 1u << i; if (MODE == 0) rowoff = (ent_[i] & 0xffffu); else rowoff = (unsigned)(J.rowbase + idx); } \
            if (i & 1) arow[i >> 1] |= rowoff << 16; else arow[i >> 1] = rowoff; } \
        int kr_ = tid_s >> 5; const int c4_ = tid_s & 31;     \
        if (MODE == 0) bp = (c4_ < 16 ? P.W0 : P.W1) + (size_t)J.e * 2048 * 512 + J.ns * 64 + (c4_ & 15) * 4 + (size_t)kr_ * LDN; \
        else { bp = P.W0 + (size_t)J.e * 512 * 2048 + J.ns * 128 + c4_ * 4 + (size_t)kr_ * LDN; \
               if (tid_s < TM) { const int idx_ = J.mt * TM + tid_s; int ent_ = -1; float w_ = 0.f; if (idx_ < J.cnt) { ent_ = P.bucket[J.e * 8192 + idx_]; w_ = P.bucket_w[J.e * 8192 + idx_]; } \
                   tabE[(ui & 1) * TM + tid_s] = ent_; tabW[(ui & 1) * TM + tid_s] = w_; } } ++ui; } while (0)
#define MG_LOAD(SA, SB, t_) do { _Pragma("unroll") for (int i = 0; i < 6; ++i) if (avalid & (1u << i)) SA[i] = *(const u32x4*)(P.Abase + (size_t)(((arow[i >> 1] >> (16 * (i & 1))) & 0xffffu) * (unsigned)AROW + (unsigned)ach * 16u) + (size_t)(((t_) + koff) & (NT - 1)) * 128); \
          \
          \
        { const float* p_ = bp + (size_t)(64 * (((t_) + koff) & (NT - 1))) * LDN; asm volatile("" : "+v"(p_)); _Pragma("unroll") for (int i = 0; i < 4; ++i) SB[i] = __builtin_nontemporal_load((const __attribute__((address_space(1))) u32x4*)(p_ + (size_t)(16 * i) * LDN)); } } while (0)
#define MG_WRITE(SA, SB, buf) do { _Pragma("unroll") for (int i = 0; i < 4; ++i) { const unsigned k = (unsigned)(kr + 16 * i); \
            u32x2 w; w.x = cvt2(__uint_as_float(SB[i].x), __uint_as_float(SB[i].y)); w.y = cvt2(__uint_as_float(SB[i].z), __uint_as_float(SB[i].w)); \
            *(MLAS u32x2*)(Bl + (buf) * B_BYTES + off_b(k, (unsigned)(c4 >> 1)) + (unsigned)(c4 & 1) * 8u) = w; } \
        _Pragma("unroll") for (int i = 0; i < 6; ++i) *(MLAS u32x4*)(Al + (buf) * A_BYTES + awr0 + i * 8192) = SA[i]; } while (0)
    MG_JOB(L); MG_SETUP(); MG_LOAD(sa0, sb0, 0); MG_LOAD(sa1, sb1, 1);
    for (;;) {
        f32x16 acc[3][2];
#pragma unroll
        for (int a = 0; a < 3; ++a)
#pragma unroll
            for (int b = 0; b < 2; ++b) acc[a][b] = f32x16{};
        MG_WRITE(sa0, sb0, 0); MG_LOAD(sa0, sb0, 2);
        __syncthreads();
#define MG_ITER(t_, SA, SB, WR_, LD_) do { const int t = (t_); const int cur = t & 1; \
        { const MLAS char* Ac = Al + cur * A_BYTES; const MLAS char* Bc = Bl + cur * B_BYTES; \
          _Pragma("unroll") for (int s = 0; s < 4; ++s) { \
            const bf16x8 a0 = *(const MLAS bf16x8*)(Ac + MG_AOFF(s)), a1 = *(const MLAS bf16x8*)(Ac + MG_AOFF(s) + 32 * 128), a2 = *(const MLAS bf16x8*)(Ac + MG_AOFF(s) + 64 * 128); \
            const s16x4 l0 = vtr(Bc + MG_BOFF(0, 0) + s * 4096), h0 = vtr(Bc + MG_BOFF(0, 1) + s * 4096), l1 = vtr(Bc + MG_BOFF(1, 0) + s * 4096), h1 = vtr(Bc + MG_BOFF(1, 1) + s * 4096); \
            const bf16x8 b0 = {l0[0], l0[1], l0[2], l0[3], h0[0], h0[1], h0[2], h0[3]}, b1 = {l1[0], l1[1], l1[2], l1[3], h1[0], h1[1], h1[2], h1[3]}; \
            acc[0][0] = __builtin_amdgcn_mfma_f32_32x32x16_bf16(a0, b0, acc[0][0], 0, 0, 0); acc[0][1] = __builtin_amdgcn_mfma_f32_32x32x16_bf16(a0, b1, acc[0][1], 0, 0, 0); \
            acc[1][0] = __builtin_amdgcn_mfma_f32_32x32x16_bf16(a1, b0, acc[1][0], 0, 0, 0); acc[1][1] = __builtin_amdgcn_mfma_f32_32x32x16_bf16(a1, b1, acc[1][1], 0, 0, 0); \
            acc[2][0] = __builtin_amdgcn_mfma_f32_32x32x16_bf16(a2, b0, acc[2][0], 0, 0, 0); acc[2][1] = __builtin_amdgcn_mfma_f32_32x32x16_bf16(a2, b1, acc[2][1], 0, 0, 0); __builtin_amdgcn_sched_barrier(0); } } \
        if (WR_) { MG_WRITE(SA, SB, cur ^ 1); if (LD_) MG_LOAD(SA, SB, t + 3); } \
        __syncthreads(); } while (0)
        for (int t2 = 0; t2 < NT - 4; t2 += 2) {
            MG_ITER(t2, sa1, sb1, true, true);
            MG_ITER(t2 + 1, sa0, sb0, true, true);
        }
        MG_ITER(NT - 4, sa1, sb1, true, true);
        MG_ITER(NT - 3, sa0, sb0, true, false);
        MG_ITER(NT - 2, sa1, sb1, true, false);
        MG_ITER(NT - 1, sa0, sb0, false, false);
        const MoeJob Jc = J; const int par = (ui - 1) & 1; (void)par;
        const int Ln = L + G; const bool more = Ln < total;
        if (more) { MG_JOB(Ln); MG_SETUP(); MG_LOAD(sa0, sb0, 0); MG_LOAD(sa1, sb1, 1); }
        int ln = lane; asm volatile("" : "+v"(ln));
        const int r32e = ln & 31, hie = ln >> 5;
        if (MODE == 0) {
            MLAS char* S1 = Al + wave * 6144 + hie * 256 + r32e * 2;
#pragma unroll
            for (int mt = 0; mt < 3; ++mt)
#pragma unroll
                for (int r = 0; r < 16; ++r) { const float g = acc[mt][0][r], u = acc[mt][1][r];
                    const float v = g * __builtin_amdgcn_rcpf(1.0f + __builtin_amdgcn_exp2f(-1.4426950408889634f * g)) * u; const float vn = quad_xor<1>(v);
                    if ((r32e & 1) == 0) *(MLAS unsigned*)(S1 + (mt * 32 + (r & 3) + 8 * (r >> 2)) * 64) = cvt2(v, vn); }
            __builtin_amdgcn_sched_barrier(0);
            const MLAS char* S2 = Al + wave * 6144 + (ln >> 2) * 64 + (ln & 3) * 16; const int idx0 = Jc.mt * TM + wm * 96 + (ln >> 2);
            unsigned short* hp = P.H + (size_t)(Jc.rowbase + idx0) * 512 + Jc.ns * 64 + wn * 32 + (ln & 3) * 8;
#pragma unroll
            for (int k = 0; k < 6; ++k) { if (k == 3) __builtin_amdgcn_sched_barrier(0);
                const u32x4 w = *(const MLAS u32x4*)(S2 + k * 1024);
                if (idx0 + 16 * k < Jc.cnt) *(u32x4*)(hp + (size_t)(16 * k) * 512) = w; }
        } else {
            MLAS char* S1 = Al + wave * 12288 + hie * 512 + r32e * 2;
            const MLAS float* tw = tabW + par * TM + wm * 96 + 4 * hie;
#pragma unroll
            for (int mt = 0; mt < 3; ++mt) { float wg[16];
#pragma unroll
                for (int r = 0; r < 16; ++r) wg[r] = tw[mt * 32 + (r & 3) + 8 * (r >> 2)];
                __builtin_amdgcn_sched_barrier(0);
#pragma unroll
                for (int r = 0; r < 16; ++r) { const int rowc = mt * 32 + (r & 3) + 8 * (r >> 2);
#pragma unroll
                    for (int j = 0; j < 2; ++j) { const float v = acc[mt][j][r] * wg[r]; const float vn = quad_xor<1>(v);
                        if ((r32e & 1) == 0) *(MLAS unsigned*)(S1 + rowc * 128 + j * 64) = cvt2(v, vn); } } }
            __builtin_amdgcn_sched_barrier(0);
            const MLAS char* S2 = Al + wave * 12288 + (ln >> 3) * 128 + (ln & 7) * 16; const MLAS int* te = tabE + par * TM + wm * 96 + (ln >> 3);
            const int coff = Jc.ns * 128 + (wn + 2 * ((ln & 7) >> 2)) * 32 + (ln & 3) * 8;
#pragma unroll
            for (int k = 0; k < 12; ++k) { if ((k & 3) == 0 && k) __builtin_amdgcn_sched_barrier(0);
                const int ent = te[8 * k]; const u32x4 w = *(const MLAS u32x4*)(S2 + k * 1024);
                if (ent >= 0) *(u32x4*)(P.Y + ((size_t)((ent >> 16) * 8192 + (ent & 0xffff)) * 2048 + coff)) = w; }
        }
        if (more) __syncthreads();
        if (!more) break;
        L = Ln;
    }
#undef MG_AOFF
#undef MG_BOFF
#undef MG_ITER
#undef MG_JOB
#undef MG_SETUP
#undef MG_LOAD
#undef MG_WRITE
    __syncthreads();
}
}
namespace att {
#define ALAS __attribute__((address_space(3)))
typedef unsigned short bf16;
typedef short bf16x8 __attribute__((ext_vector_type(8)));
typedef short s16x4 __attribute__((ext_vector_type(4)));
typedef float f32x16 __attribute__((ext_vector_type(16)));
typedef float f32x4 __attribute__((ext_vector_type(4)));
typedef unsigned u32x4 __attribute__((ext_vector_type(4)));
constexpr int SHM_V = 16384, SHM_K = 16384;
constexpr int A_V = 0, A_K = 32768, A_U = 0  , A_WS = 98304  , A_BT = A_WS + 2048  , A_MISC = A_BT + 2048;
constexpr float NEG_INF = -__builtin_inff();
constexpr float THR = 8.f;
enum { M_CMP = 0, M_SEL = 1, M_WIN = 2, M_MOBA = 3 };

#define KSWZ(row, colB) ((row) * 256 + ((colB) ^ (((row) & 15) << 4)))
#define SBAR() __builtin_amdgcn_sched_barrier(0)
__device__ __forceinline__ int v_st(int k, int c) { const int kk = (k & ~0xC) | ((k & 4) << 1) | ((k & 8) >> 1); return ((kk >> 3) * 4 + (c >> 5)) * 512 + ((kk & 7) * 32 + (c & 31)) * 2; }
__device__ __forceinline__ int v_rd_base(int lane) { return ((lane & 3) << 3) | (((lane >> 2) & 3) << 6) | (((lane >> 4) & 1) << 5) | (((lane >> 5) & 1) << 8); }
constexpr int v_rd_off(int d0, int ks, int half) { return d0 * 512 + ks * 4096 + half * 2048; }
__device__ __forceinline__ int crow(int r, int hi) { return (r & 3) + 8 * (r >> 2) + 4 * hi; }
typedef float f32x2_cv __attribute__((ext_vector_type(2))); typedef __bf16 bf16x2_cv __attribute__((ext_vector_type(2)));
__device__ __forceinline__ unsigned cvtpk(float lo, float hi) { f32x2_cv v = {lo, hi}; bf16x2_cv b = __builtin_convertvector(v, bf16x2_cv); return __builtin_bit_cast(unsigned, b); }

template <bool ONLY32>
__device__ __forceinline__ void qkt(f32x16& p0, f32x16& p1, const ALAS char* kbuf, int r32, int hi, const bf16x8 (&qr)[8]) {
    p0 = f32x16{}; p1 = f32x16{};
    if (ONLY32) {
#pragma unroll
        for (int d0 = 0; d0 < 8; ++d0) { const bf16x8 b0 = *reinterpret_cast<const ALAS bf16x8*>(kbuf + KSWZ(r32, (d0 * 16 + hi * 8) * 2));
            p0 = __builtin_amdgcn_mfma_f32_32x32x16_bf16(b0, qr[d0], p0, 0, 0, 0); }
    } else {
        unsigned ka[8];
#pragma unroll
        for (int dd = 0; dd < 8; ++dd) ka[dd] = (unsigned)(size_t)kbuf + (unsigned)KSWZ(r32, (dd * 16 + hi * 8) * 2);
        bf16x8 kb0, kb1, kb2, kb3;
#define KRD(dst, f) asm volatile("ds_read_b128 %0, %1 offset:%2" : "=&v"(dst) : "v"(ka[(f) >> 1]), "i"(((f) & 1) * 8192) : "memory")
#define KWT(dst, n) asm volatile("s_waitcnt lgkmcnt(" #n ")" : "+v"(dst) :: "memory")
#define KMM(dst, f) do { if (((f) & 1) == 0) p0 = __builtin_amdgcn_mfma_f32_32x32x16_bf16(dst, qr[(f) >> 1], p0, 0, 0, 0); else p1 = __builtin_amdgcn_mfma_f32_32x32x16_bf16(dst, qr[(f) >> 1], p1, 0, 0, 0); } while (0)
#define KSTEP(dst, f, n) do { KWT(dst, n); SBAR(); KMM(dst, f); SBAR(); if ((f) + 4 < 16) KRD(dst, (f) + 4); } while (0)
        KRD(kb0, 0); KRD(kb1, 1); KRD(kb2, 2); KRD(kb3, 3);
        KSTEP(kb0, 0, 3); KSTEP(kb1, 1, 3); KSTEP(kb2, 2, 3); KSTEP(kb3, 3, 3);
        KSTEP(kb0, 4, 3); KSTEP(kb1, 5, 3); KSTEP(kb2, 6, 3); KSTEP(kb3, 7, 3);
        KSTEP(kb0, 8, 3); KSTEP(kb1, 9, 3); KSTEP(kb2, 10, 3); KSTEP(kb3, 11, 3);
        KSTEP(kb0, 12, 3); KSTEP(kb1, 13, 2); KSTEP(kb2, 14, 1); KSTEP(kb3, 15, 0);
#undef KSTEP
#undef KMM
#undef KWT
#undef KRD
    }
}
__device__ __forceinline__ void pv_tile(f32x16 (&o)[4], unsigned vb, bf16x8 pa0, bf16x8 pa1, bf16x8 pa2, bf16x8 pa3) {
#define TRRD(dst, off) asm volatile("ds_read_b64_tr_b16 %0, %1 offset:%2" : "=&v"(dst) : "v"(vb), "i"(off) : "memory")
#define PV_RD(S, d0) do { constexpr int b_ = v_rd_off(d0, 0, 0); \
        TRRD(S##l0, b_); TRRD(S##h0, b_ + 2048); TRRD(S##l1, b_ + 4096); TRRD(S##h1, b_ + 6144); TRRD(S##l2, b_ + 8192); TRRD(S##h2, b_ + 10240); TRRD(S##l3, b_ + 12288); TRRD(S##h3, b_ + 14336); } while (0)
#define PV_MM(S, d0) do { \
        o[d0] = __builtin_amdgcn_mfma_f32_32x32x16_bf16(pa0, (bf16x8){S##l0[0], S##l0[1], S##l0[2], S##l0[3], S##h0[0], S##h0[1], S##h0[2], S##h0[3]}, o[d0], 0, 0, 0);   \
        o[d0] = __builtin_amdgcn_mfma_f32_32x32x16_bf16(pa1, (bf16x8){S##l1[0], S##l1[1], S##l1[2], S##l1[3], S##h1[0], S##h1[1], S##h1[2], S##h1[3]}, o[d0], 0, 0, 0);   \
        o[d0] = __builtin_amdgcn_mfma_f32_32x32x16_bf16(pa2, (bf16x8){S##l2[0], S##l2[1], S##l2[2], S##l2[3], S##h2[0], S##h2[1], S##h2[2], S##h2[3]}, o[d0], 0, 0, 0);   \
        o[d0] = __builtin_amdgcn_mfma_f32_32x32x16_bf16(pa3, (bf16x8){S##l3[0], S##l3[1], S##l3[2], S##l3[3], S##h3[0], S##h3[1], S##h3[2], S##h3[3]}, o[d0], 0, 0, 0); } while (0)
#define PV_W(n) do { asm volatile("s_waitcnt lgkmcnt(" #n ")" ::: "memory"); SBAR(); } while (0)
    {
        s16x4 Al0, Al1, Al2, Al3, Ah0, Ah1, Ah2, Ah3, Bl0, Bl1, Bl2, Bl3, Bh0, Bh1, Bh2, Bh3;
        PV_RD(A, 0); PV_RD(B, 1); PV_W(8); PV_MM(A, 0); SBAR();
        PV_RD(A, 2); PV_W(8); PV_MM(B, 1); SBAR();
        PV_RD(B, 3); PV_W(8); PV_MM(A, 2); SBAR();
        PV_W(0); PV_MM(B, 3);
    }
#undef PV_RD
#undef PV_MM
#undef PV_W
#undef TRRD
}

__device__ __forceinline__ void attn_prefetch(const bf16* Kg, const bf16* Vg, int j, ALAS unsigned char* lds) {
    int tid = threadIdx.x; asm volatile("" : "+v"(tid));
    const int wid = __builtin_amdgcn_readfirstlane(tid >> 6), lane = tid & 63;
    ALAS char* V_lds = (ALAS char*)lds + A_V; ALAS char* K_lds = (ALAS char*)lds + A_K;
    const char* kp_ = (const char*)(Kg + (size_t)j * 64 * 128); const char* vp_ = (const char*)(Vg + (size_t)j * 64 * 128);
#pragma unroll
    for (int i = 0; i < 2; ++i) { const int L = ((wid * 2 + i) * 64 + lane) * 16;
        const int row = L >> 8, cp = (L >> 4) & 15; const unsigned kof = (unsigned)(row * 256 + ((cp ^ (row & 15)) << 4));
        const int blk = L >> 9, kk = (blk >> 2) * 8 + ((L >> 6) & 7), k = (kk & ~0xC) | ((kk & 4) << 1) | ((kk & 8) >> 1);
        const unsigned vof = (unsigned)(k * 256 + (blk & 3) * 64 + ((L >> 4) & 3) * 16);
        __builtin_amdgcn_global_load_lds((const unsigned*)(kp_ + kof), (ALAS unsigned*)(K_lds + (wid * 2 + i) * 1024), 16, 0, 0);
        __builtin_amdgcn_global_load_lds((const unsigned*)(vp_ + vof), (ALAS unsigned*)(V_lds + (wid * 2 + i) * 1024), 16, 0, 0); }
}
template <int MODE, bool PRE = false>
__device__ __forceinline__ void attn_loop(f32x16 (&o)[4], float& l_out, const bf16x8 (&qr)[8], const bf16* Kg, const bf16* Vg, int j_lo, int j_hi,
                                          int pos, unsigned long long sel, int wpos0, int own, const ALAS float* btab, float c31, ALAS unsigned char* lds) {
    int tid = threadIdx.x; asm volatile("" : "+v"(tid));
    const int wid = __builtin_amdgcn_readfirstlane(tid >> 6), lane = tid & 63, r32 = lane & 31, hi = lane >> 5;
    ALAS char* V_lds = (ALAS char*)lds + A_V; ALAS char* K_lds = (ALAS char*)lds + A_K;
    ALAS float* al_l = (ALAS float*)(lds + A_WS) + wid * 64 + 32;
    const unsigned vb0 = (unsigned)(size_t)V_lds + (unsigned)v_rd_base(lane);
    constexpr int KS = (MODE == M_CMP) ? 16 : 1;
    float m_reg = -1e30f, l_reg = 0.f;
#pragma unroll
    for (int d = 0; d < 4; ++d) o[d] = f32x16{};
    unsigned kof[2], vof[2];
#pragma unroll
    for (int i = 0; i < 2; ++i) { const int L = ((wid * 2 + i) * 64 + lane) * 16;
        const int row = L >> 8, cp = (L >> 4) & 15; kof[i] = (unsigned)(row * 256 + ((cp ^ (row & 15)) << 4));
        const int blk = L >> 9, kk = (blk >> 2) * 8 + ((L >> 6) & 7), k = (kk & ~0xC) | ((kk & 4) << 1) | ((kk & 8) >> 1);
        vof[i] = (unsigned)(k * 256 + (blk & 3) * 64 + ((L >> 4) & 3) * 16); }
#define GSTAGE(j, bf) do { const char* kp_ = (const char*)(Kg + (size_t)(j) * 64 * 128); const char* vp_ = (const char*)(Vg + (size_t)(j) * 64 * 128); \
        _Pragma("unroll") for (int i_ = 0; i_ < 2; ++i_) { \
            __builtin_amdgcn_global_load_lds((const unsigned*)(kp_ + kof[i_]), (ALAS unsigned*)(K_lds + (bf) * SHM_K + (wid * 2 + i_) * 1024), 16, 0, 0); \
            __builtin_amdgcn_global_load_lds((const unsigned*)(vp_ + vof[i_]), (ALAS unsigned*)(V_lds + (bf) * SHM_V + (wid * 2 + i_) * 1024), 16, 0, 0); } } while (0)
    const int NT = j_hi - j_lo;
    if (!PRE) GSTAGE(j_lo, 0);
    asm volatile("s_waitcnt vmcnt(0)" ::: "memory");
    __syncthreads();
    if (wid < 4) __builtin_amdgcn_s_setprio(2);
    for (int t = 0; t < NT; ++t) {
        const int buf = t & 1, j = j_lo + t;
        if (t + 1 < NT) GSTAGE(j + 1, buf ^ 1);
        f32x16 p0, p1;
        qkt<false>(p0, p1, K_lds + buf * SHM_K, r32, hi, qr);
        const int kp0 = (MODE == M_CMP) ? (1024 * j + 31) : 64 * j;
        const int dmin = wpos0 - (kp0 + 63 * KS), dmax = wpos0 + 31 - kp0;
        bool rowsel = true;
        if (MODE == M_SEL) rowsel = ((sel >> j) & 1ull) != 0ull;
        if (MODE == M_MOBA) rowsel = ((j >> 2) < own) ? (((sel >> (j >> 2)) & 1ull) != 0ull) : true;
        float tb;
        if (dmin >= 113 && (MODE != M_WIN || dmax < 512)) { tb = rowsel ? c31 : NEG_INF; }
        else {
            tb = 0.f;
            int dq = pos - kp0 - KS * 4 * hi; asm volatile("" : "+v"(dq));
            const unsigned LIMIT = (MODE == M_WIN) ? 512u : 0x7fffffffu;
#pragma unroll
            for (int r = 0; r < 16; ++r) { if ((r & 3) == 0 && r) SBAR();
                const int c = (r & 3) + 8 * (r >> 2); const int d0 = dq - KS * c, d1 = d0 - KS * 32;
                const int i0 = d0 < 0 ? 0 : (d0 > 127 ? 127 : d0), i1 = d1 < 0 ? 0 : (d1 > 127 ? 127 : d1);
                const float b0 = btab[i0], b1 = btab[i1];
                const float k0 = (rowsel && (unsigned)d0 < LIMIT) ? 0.f : NEG_INF, k1 = (rowsel && (unsigned)d1 < LIMIT) ? 0.f : NEG_INF;
                p0[r] = (p0[r] + b0) + k0; p1[r] = (p1[r] + b1) + k1; }
        }
        float pmax = p0[0];
#pragma unroll
        for (int r = 1; r < 16; ++r) pmax = fmaxf(pmax, p0[r]);
#pragma unroll
        for (int r = 0; r < 16; ++r) pmax = fmaxf(pmax, p1[r]);
        { auto rr = __builtin_amdgcn_permlane32_swap(__float_as_uint(pmax), __float_as_uint(pmax), false, false);
          pmax = fmaxf(__uint_as_float(rr[0]), __uint_as_float(rr[1])); }
        const float cand = pmax + tb;
        float mn, alpha;
        if (__all((cand - m_reg) <= THR)) { mn = m_reg; alpha = 1.f; }
        else { mn = fmaxf(m_reg, cand); alpha = __builtin_amdgcn_exp2f(m_reg - mn); m_reg = mn; }
        const float off = tb - mn;
        float ps = 0.f;
#pragma unroll
        for (int r = 0; r < 16; ++r) { p0[r] = __builtin_amdgcn_exp2f(p0[r] + off); ps += p0[r]; }
#pragma unroll
        for (int r = 0; r < 16; ++r) { p1[r] = __builtin_amdgcn_exp2f(p1[r] + off); ps += p1[r]; }
        { auto rr = __builtin_amdgcn_permlane32_swap(__float_as_uint(ps), __float_as_uint(ps), false, false);
          ps = __uint_as_float(rr[0]) + __uint_as_float(rr[1]); }
        l_reg = l_reg * alpha + ps;
        bf16x8 pa0, pa1, pa2, pa3;
#define PK4(P, B_, OUT) do { unsigned a0 = cvtpk(P[B_+0], P[B_+1]), a1 = cvtpk(P[B_+2], P[B_+3]);                          \
        unsigned b0 = cvtpk(P[B_+4], P[B_+5]), b1 = cvtpk(P[B_+6], P[B_+7]);                                             \
        auto r0 = __builtin_amdgcn_permlane32_swap(a0, b0, false, false); auto r1 = __builtin_amdgcn_permlane32_swap(a1, b1, false, false); \
        u32x4 w = {r0[0], r1[0], r0[1], r1[1]}; OUT = *reinterpret_cast<bf16x8*>(&w); } while (0)
        PK4(p0, 0, pa0); PK4(p0, 8, pa1); PK4(p1, 0, pa2); PK4(p1, 8, pa3);
#undef PK4
        if (__any(alpha < 1.f)) { if (hi == 0) al_l[r32] = alpha; asm volatile("s_waitcnt lgkmcnt(0)" ::: "memory");
#pragma unroll
            for (int d_ = 0; d_ < 4; ++d_)
#pragma unroll
                for (int r = 0; r < 16; ++r) o[d_][r] *= al_l[crow(r, hi)]; }
        SBAR();
        pv_tile(o, vb0 + (unsigned)(buf * SHM_V), pa0, pa1, pa2, pa3);
        asm volatile("s_waitcnt vmcnt(0)" ::: "memory");
        __syncthreads();
    }
#undef GSTAGE
    __builtin_amdgcn_s_setprio(0);
    l_out = l_reg;
}

__device__ __forceinline__ void attn_norm(f32x16 (&o)[4], float l, float fac, ALAS unsigned char* lds) {
    const int tid = threadIdx.x, wid = __builtin_amdgcn_readfirstlane(tid >> 6), lane = tid & 63, r32 = lane & 31, hi = lane >> 5;
    ALAS float* li_l = (ALAS float*)(lds + A_WS) + wid * 64;
    if (hi == 0) li_l[r32] = (l > 0.f) ? fac * __builtin_amdgcn_rcpf(l) : 0.f;
    asm volatile("s_waitcnt lgkmcnt(0)" ::: "memory");
#pragma unroll
    for (int r = 0; r < 16; ++r) { const float f = li_l[crow(r, hi)];
#pragma unroll
        for (int d0 = 0; d0 < 4; ++d0) o[d0][r] *= f; }
    asm volatile("s_waitcnt lgkmcnt(0)" ::: "memory");
}
constexpr int A_ST0 = 65536, A_ST1 = 103424;
template <bool ACC>
__device__ __forceinline__ void attn_store_bf16(const f32x16 (&o)[4], bf16* Ow, int pitch, ALAS unsigned char* lds) {
    int tid_ = threadIdx.x; asm volatile("" : "+v"(tid_));
    const int wid = __builtin_amdgcn_readfirstlane(tid_ >> 6), lane = tid_ & 63, r32 = lane & 31, hi = lane >> 5;
    ALAS unsigned char* S = lds + (wid < 4 ? A_ST0 + wid * 8192 : A_ST1 + (wid - 4) * 8192);
    u32x4 old[8];
    const int row0 = lane >> 4, ch = lane & 15;
    if (ACC) {
#pragma unroll
        for (int k = 0; k < 8; ++k) old[k] = *(const u32x4*)(Ow + (size_t)(4 * k + row0) * pitch + ch * 8);
    }
#pragma unroll
    for (int r = 0; r < 16; ++r)
#pragma unroll
        for (int d0 = 0; d0 < 4; ++d0) { const float v = o[d0][r]; const float vn = quad_xor<1>(v);
            if ((r32 & 1) == 0) *(ALAS unsigned*)(S + crow(r, hi) * 256 + (d0 * 32 + r32) * 2) = cvtpk(v, vn); }
#pragma unroll
    for (int k = 0; k < 8; ++k) { u32x4 w = *(const ALAS u32x4*)(S + (4 * k + row0) * 256 + ch * 16);
        if (ACC) { const u32x4 q = old[k];
            w.x = cvtpk(__uint_as_float(w.x << 16) + __uint_as_float(q.x << 16), __uint_as_float(w.x & 0xffff0000u) + __uint_as_float(q.x & 0xffff0000u));
            w.y = cvtpk(__uint_as_float(w.y << 16) + __uint_as_float(q.y << 16), __uint_as_float(w.y & 0xffff0000u) + __uint_as_float(q.y & 0xffff0000u));
            w.z = cvtpk(__uint_as_float(w.z << 16) + __uint_as_float(q.z << 16), __uint_as_float(w.z & 0xffff0000u) + __uint_as_float(q.z & 0xffff0000u));
            w.w = cvtpk(__uint_as_float(w.w << 16) + __uint_as_float(q.w << 16), __uint_as_float(w.w & 0xffff0000u) + __uint_as_float(q.w & 0xffff0000u)); }
        *(u32x4*)(Ow + (size_t)(4 * k + row0) * pitch + ch * 8) = w; }
}
template <bool ACC>
__device__ __forceinline__ void attn_store_f8(const f32x16 (&o)[4], const bf16* Oold, int pitch, unsigned char* O8, int pitch8, ALAS unsigned char* lds) {
    typedef unsigned u32x2s __attribute__((ext_vector_type(2)));
    int tid_ = threadIdx.x; asm volatile("" : "+v"(tid_));
    const int wid = __builtin_amdgcn_readfirstlane(tid_ >> 6), lane = tid_ & 63, r32 = lane & 31, hi = lane >> 5;
    ALAS unsigned char* S = lds + (wid < 4 ? A_ST0 + wid * 8192 : A_ST1 + (wid - 4) * 8192);
    u32x4 old[8];
    const int row0 = lane >> 4, ch = lane & 15;
    if (ACC) {
#pragma unroll
        for (int k = 0; k < 8; ++k) old[k] = *(const u32x4*)(Oold + (size_t)(4 * k + row0) * pitch + ch * 8);
    }
#pragma unroll
    for (int r = 0; r < 16; ++r)
#pragma unroll
        for (int d0 = 0; d0 < 4; ++d0) { const float v = o[d0][r]; const float vn = quad_xor<1>(v);
            if ((r32 & 1) == 0) *(ALAS unsigned*)(S + crow(r, hi) * 256 + (d0 * 32 + r32) * 2) = cvtpk(v, vn); }
#pragma unroll
    for (int k = 0; k < 8; ++k) { const u32x4 w = *(const ALAS u32x4*)(S + (4 * k + row0) * 256 + ch * 16);
        float f[8] = {__uint_as_float(w.x << 16), __uint_as_float(w.x & 0xffff0000u), __uint_as_float(w.y << 16), __uint_as_float(w.y & 0xffff0000u),
                      __uint_as_float(w.z << 16), __uint_as_float(w.z & 0xffff0000u), __uint_as_float(w.w << 16), __uint_as_float(w.w & 0xffff0000u)};
        if (ACC) { const u32x4 q = old[k];
            f[0] += __uint_as_float(q.x << 16); f[1] += __uint_as_float(q.x & 0xffff0000u); f[2] += __uint_as_float(q.y << 16); f[3] += __uint_as_float(q.y & 0xffff0000u);
            f[4] += __uint_as_float(q.z << 16); f[5] += __uint_as_float(q.z & 0xffff0000u); f[6] += __uint_as_float(q.w << 16); f[7] += __uint_as_float(q.w & 0xffff0000u); }
        int q0 = __builtin_amdgcn_cvt_pk_fp8_f32(f[0] * 16.f, f[1] * 16.f, 0, false); q0 = __builtin_amdgcn_cvt_pk_fp8_f32(f[2] * 16.f, f[3] * 16.f, q0, true);
        int q1 = __builtin_amdgcn_cvt_pk_fp8_f32(f[4] * 16.f, f[5] * 16.f, 0, false); q1 = __builtin_amdgcn_cvt_pk_fp8_f32(f[6] * 16.f, f[7] * 16.f, q1, true);
        u32x2s qq; qq.x = (unsigned)q0; qq.y = (unsigned)q1;
        *(u32x2s*)(O8 + (size_t)(4 * k + row0) * pitch8 + ch * 8) = qq; }
}
__device__ __forceinline__ void load_q(bf16x8 (&qr)[8], const bf16* Qw) {
    int tid_ = threadIdx.x; asm volatile("" : "+v"(tid_));
    const int lane = tid_ & 63, r32 = lane & 31, hi = lane >> 5;
#pragma unroll
    for (int d0 = 0; d0 < 8; ++d0) qr[d0] = *(const bf16x8*)(Qw + (size_t)r32 * 128 + d0 * 16 + hi * 8);
}
}
constexpr int NWAVES = 8;
constexpr int DM = 2048, SEQ = 4096, TOK = 8192, HD = 128;
constexpr int NPROJ = 9984;
constexpr float RMS_EPS = 1e-6f;
constexpr float LOG2E = 1.4426950408889634f;
constexpr float QSCALE = 0.08838834764831845f * 1.4426950408889634f;

constexpr size_t MiB = 1u << 20;
constexpr size_t WS_CTL = 0, CTL_ZERO_BYTES = 64 * 1024;
constexpr size_t WS_WIN_T = 2 * MiB;
constexpr size_t WS_WA_T = 42 * MiB;
constexpr size_t WS_WB_T = 46 * MiB;
constexpr size_t WS_WO_T = 50 * MiB;
constexpr size_t WS_W1K_T = 58 * MiB;
constexpr size_t WS_W1V_T = 60 * MiB;
constexpr size_t WS_WR_T = 62 * MiB;
constexpr size_t WS_CV = 63 * MiB;
constexpr size_t WS_CMPK = WS_CV + 64 * 1024;
constexpr size_t WS_CMPV = WS_CMPK + 256 * 1024;
constexpr size_t WS_OV = WS_CMPV + 256 * 1024;
constexpr size_t WS_KM = WS_OV + 64 * 1024;
constexpr size_t WS_XN = 64 * MiB;
constexpr size_t WS_QA = 96 * MiB;
constexpr size_t WS_KV6 = 112 * MiB;
constexpr size_t WS_QKVB = 136 * MiB;
constexpr size_t WS_GM = 184 * MiB;
constexpr size_t WS_GATE = 248 * MiB;
constexpr size_t WS_SSQ = 249 * MiB;
constexpr size_t WS_P = 420 * MiB;
constexpr size_t WS_OA = 254 * MiB;
constexpr size_t WS_OB = 270 * MiB;
constexpr size_t WS_MRG = 286 * MiB;
constexpr size_t WS_H = 318 * MiB;
constexpr size_t WS_Y = 350 * MiB;
constexpr size_t WS_BKT = 414 * MiB;
constexpr size_t WS_BKTW = 416 * MiB;
constexpr size_t WS_END = 452 * MiB;
constexpr int CW_TMO = 0, CW_CODE = 1, CW_BAR = 4096, CW_CNT = 8192  , CW_ERR = 9216  ;
constexpr int RING_OFF = 0, RING_BYTES = 139264;
constexpr int LDSCTL_OFF = RING_BYTES, MISC_OFF = LDSCTL_OFF, TILES_OFF = LDSCTL_OFF + 256;
constexpr int LDS_BYTES = 147456;
static_assert(TILES_OFF + 128 * 16 <= LDS_BYTES, "LDS map");

#define GAS __attribute__((address_space(1)))
#define LAS __attribute__((address_space(3)))
typedef unsigned short bf16;
typedef unsigned v4u __attribute__((ext_vector_type(4)));
typedef unsigned v2u __attribute__((ext_vector_type(2)));
typedef float f32x4 __attribute__((ext_vector_type(4)));
typedef short bf16x8 __attribute__((ext_vector_type(8)));
typedef GAS unsigned gu32;
#define RLX_AGENT __ATOMIC_RELAXED, __HIP_MEMORY_SCOPE_AGENT
#define LDS_WAIT() asm volatile("s_waitcnt lgkmcnt(0)" ::: "memory")
#define VM_WAIT() asm volatile("s_waitcnt vmcnt(0)" ::: "memory")
__device__ __forceinline__ unsigned f2bf(float f) { unsigned u = __builtin_bit_cast(unsigned, f); return (u + 0x7fffu + ((u >> 16) & 1u)) >> 16; }
__device__ __forceinline__ unsigned pk2(float lo, float hi) { return f2bf(lo) | (f2bf(hi) << 16); }
__device__ __forceinline__ float bf2f(unsigned h) { return __uint_as_float(h << 16); }

#define XB_TMO      128
#define XB_XCNT(j)  (256  + 64 * (j))
#define XB_XSUB(j)  (1280 + 64 * (j))
#define XB_XGEN(j)  (2304 + 64 * (j))
#define XB_TOP      3328
#define XB_TOPGEN   3392
#define XCD_BAR_WORDS 3456
#define XB_SPIN_CAP (1u << 18)
__device__ __forceinline__ unsigned xb_ld(unsigned* p)              { return __hip_atomic_load(p, __ATOMIC_RELAXED, __HIP_MEMORY_SCOPE_AGENT); }
__device__ __forceinline__ unsigned xb_add(unsigned* p, unsigned v) { return __hip_atomic_fetch_add(p, v, __ATOMIC_RELAXED, __HIP_MEMORY_SCOPE_AGENT); }
__device__ __forceinline__ unsigned xb_xcc_id() { return (unsigned)__builtin_amdgcn_s_getreg((3 << 11) | 20) & 0xFu; }
#define XB_SPIN(cond, bar) do { unsigned _sp = 0; while (cond) { __builtin_amdgcn_s_sleep(1); \
    if ((++_sp & 255u) == 0u) { if (xb_ld(&(bar)[XB_TMO])) break; if (_sp > XB_SPIN_CAP) { atomicAdd(&(bar)[XB_TMO], 1u); break; } } } } while (0)
struct XcdBarrier { unsigned* bar; unsigned x; volatile LAS unsigned* st; };
__device__ __forceinline__ XcdBarrier xcd_barrier_post(unsigned* bar, volatile LAS unsigned* st) {
    XcdBarrier b; b.bar = bar; b.x = xb_xcc_id(); b.st = st;
    if (threadIdx.x == 0) (void)xb_add(&bar[XB_XCNT(b.x)], 1u);
    return b;
}
__device__ __forceinline__ void xcd_barrier_complete(unsigned* bar, unsigned x, unsigned& nloc, unsigned& nx) {
    const unsigned G = gridDim.x * gridDim.y * gridDim.z;
    unsigned sum, cnt, mine, sp = 0u;
    for (;;) {
        sum = 0u; cnt = 0u; mine = 0u;
#pragma unroll
        for (unsigned j = 0; j < 16; ++j) { const unsigned c = xb_ld(&bar[XB_XCNT(j)]); sum += c; cnt += (c > 0u) ? 1u : 0u; mine = (j == x) ? c : mine; }
        if (sum == G) break;
        __builtin_amdgcn_s_sleep(1);
        if ((++sp & 255u) == 0u) { if (xb_ld(&bar[XB_TMO])) break; if (sp > XB_SPIN_CAP) { atomicAdd(&bar[XB_TMO], 1u); break; } }
    }
    nloc = mine > 0u ? mine : 1u; nx = cnt > 0u ? cnt : 1u;
}
__device__ __forceinline__ void xcd_barrier(const XcdBarrier& b) {
    asm volatile("s_waitcnt vmcnt(0)" ::: "memory");
    __syncthreads();
    if (threadIdx.x == 0) {
        unsigned* bar = b.bar;
        __builtin_amdgcn_s_waitcnt(0);
        unsigned nloc = b.st[0], nx = b.st[1];
        if (nloc == 0u) { xcd_barrier_complete(bar, b.x, nloc, nx); b.st[0] = nloc; b.st[1] = nx; }
        const unsigned old = xb_add(&bar[XB_XSUB(b.x)], 1u);
        const unsigned gen = old / nloc;
        if (old + 1u == (gen + 1u) * nloc) {
            __builtin_amdgcn_fence(__ATOMIC_RELEASE, "agent");
            asm volatile("s_waitcnt vmcnt(0)" ::: "memory");
            const unsigned og = xb_add(&bar[XB_TOP], 1u);
            const unsigned tg = og / nx;
            if (og + 1u == (tg + 1u) * nx) xb_add(&bar[XB_TOPGEN], 1u);
            else XB_SPIN(xb_ld(&bar[XB_TOPGEN]) == tg, bar);
            __builtin_amdgcn_fence(__ATOMIC_ACQUIRE, "agent");
            xb_add(&bar[XB_XGEN(b.x)], 1u);
            asm volatile("s_waitcnt vmcnt(0)" ::: "memory");
        } else {
            XB_SPIN(xb_ld(&bar[XB_XGEN(b.x)]) == gen, bar);
            __builtin_amdgcn_fence(__ATOMIC_ACQUIRE, "agent");
            asm volatile("s_waitcnt vmcnt(0)" ::: "memory");
        }
    }
    __syncthreads();
}

__device__ __forceinline__ float wave_sum(float v) {
#pragma unroll
    for (int o = 1; o < 64; o <<= 1) v += __shfl_xor(v, o);
    return v;
}
__device__ __forceinline__ int rel_bucket(int n) {
    if (n < 16) return n;
    return 16 + (n >= 19) + (n >= 21) + (n >= 24) + (n >= 27) + (n >= 31) + (n >= 35) + (n >= 40) + (n >= 46) + (n >= 52) + (n >= 59) + (n >= 67) + (n >= 77) + (n >= 87) + (n >= 99) + (n >= 113);
}
__device__ __forceinline__ int wcol_src(int n) { return n < 2560 ? n : (n < 9728 ? n + 24 : (n < 9752 ? n - 9728 + 2560 : -1)); }

__device__ __forceinline__ void tr_item64(const float* src, int ldw, int scol4, float sc, bf16* dst, int ldk, LAS float* scr, int lane) {
    const int n4 = lane & 15, kk = lane >> 4;
    f32x4 v[16];
#pragma unroll
    for (int i = 0; i < 16; ++i) v[i] = scol4 >= 0 ? __builtin_nontemporal_load((const GAS f32x4*)(src + (size_t)(4 * i + kk) * ldw + scol4)) : (f32x4){0.f, 0.f, 0.f, 0.f};
    __builtin_amdgcn_sched_barrier(0);
#pragma unroll
    for (int i = 0; i < 16; ++i) *(LAS f32x4*)(scr + (4 * i + kk) * 68 + 4 * n4) = v[i] * sc;
    LDS_WAIT(); asm volatile("" ::: "memory");
    const int c = lane & 7;
#pragma unroll
    for (int j = 0; j < 8; ++j) { const int n = (lane >> 3) + 8 * j; const LAS float* s = scr + (8 * c) * 68 + n;
        v4u o; o.x = pk2(s[0 * 68], s[1 * 68]); o.y = pk2(s[2 * 68], s[3 * 68]); o.z = pk2(s[4 * 68], s[5 * 68]); o.w = pk2(s[6 * 68], s[7 * 68]);
        *(GAS v4u*)(dst + (size_t)n * ldk + 8 * c) = o; }
    LDS_WAIT(); asm volatile("" ::: "memory");
}
__device__ __forceinline__ void tr_item64_f8(const float* src, int ldw, int scol4, float sc, unsigned char* dst, int ldk, LAS float* scr, int lane) {
    const int n4 = lane & 15, kk = lane >> 4;
    f32x4 v[16];
#pragma unroll
    for (int i = 0; i < 16; ++i) v[i] = scol4 >= 0 ? __builtin_nontemporal_load((const GAS f32x4*)(src + (size_t)(4 * i + kk) * ldw + scol4)) : (f32x4){0.f, 0.f, 0.f, 0.f};
    __builtin_amdgcn_sched_barrier(0);
#pragma unroll
    for (int i = 0; i < 16; ++i) *(LAS f32x4*)(scr + (4 * i + kk) * 68 + 4 * n4) = v[i] * sc;
    LDS_WAIT(); asm volatile("" ::: "memory");
    const int c = lane & 3;
#pragma unroll
    for (int j = 0; j < 4; ++j) { const int n = (lane >> 2) + 16 * j; const LAS float* s = scr + (16 * c) * 68 + n; v4u o;
        { int q = __builtin_amdgcn_cvt_pk_fp8_f32(s[0 * 68], s[1 * 68], 0, false); q = __builtin_amdgcn_cvt_pk_fp8_f32(s[2 * 68], s[3 * 68], q, true); o.x = (unsigned)q; }
        { int q = __builtin_amdgcn_cvt_pk_fp8_f32(s[4 * 68], s[5 * 68], 0, false); q = __builtin_amdgcn_cvt_pk_fp8_f32(s[6 * 68], s[7 * 68], q, true); o.y = (unsigned)q; }
        { int q = __builtin_amdgcn_cvt_pk_fp8_f32(s[8 * 68], s[9 * 68], 0, false); q = __builtin_amdgcn_cvt_pk_fp8_f32(s[10 * 68], s[11 * 68], q, true); o.z = (unsigned)q; }
        { int q = __builtin_amdgcn_cvt_pk_fp8_f32(s[12 * 68], s[13 * 68], 0, false); q = __builtin_amdgcn_cvt_pk_fp8_f32(s[14 * 68], s[15 * 68], q, true); o.w = (unsigned)q; }
        *(GAS v4u*)(dst + (size_t)n * ldk + 16 * c) = o; }
    LDS_WAIT(); asm volatile("" ::: "memory");
}
__device__ __forceinline__ void rms_row_to_fp8(const float* xrow, const float* gain, unsigned char* orow, int lane) {
    const GAS f32x4* xr = (const GAS f32x4*)xrow + lane; const GAS f32x4* gr = (const GAS f32x4*)gain + lane;
    f32x4 v[8], gv[8]; float s = 0.f;
#pragma unroll
    for (int j = 0; j < 8; ++j) { v[j] = __builtin_nontemporal_load(xr + 64 * j); gv[j] = gr[64 * j]; s += (v[j].x * v[j].x + v[j].y * v[j].y) + (v[j].z * v[j].z + v[j].w * v[j].w); }
    const float rstd = 1.f / sqrtf(wave_sum(s) * (1.f / DM) + RMS_EPS);
    GAS unsigned* o4 = (GAS unsigned*)orow + lane;
#pragma unroll
    for (int j = 0; j < 8; ++j) { const f32x4 g = gv[j]; int q = __builtin_amdgcn_cvt_pk_fp8_f32(v[j].x * rstd * g.x, v[j].y * rstd * g.y, 0, false); q = __builtin_amdgcn_cvt_pk_fp8_f32(v[j].z * rstd * g.z, v[j].w * rstd * g.w, q, true); o4[64 * j] = (unsigned)q; }
}
__device__ __forceinline__ float gelu_tanh(float x) {
    const float u = 0.7978845608028654f * (x + 0.044715f * x * x * x);
    const float e = __builtin_amdgcn_exp2f(2.f * LOG2E * u);
    const float th = 1.f - 2.f * __builtin_amdgcn_rcpf(e + 1.f);
    return 0.5f * x * (1.f + th);
}
struct Args { const float* in[22]; float* out; unsigned char* ws; };
enum { I_X = 0, I_REL = 1, I_NMIX = 2, I_WIN = 3, I_PEK = 4, I_W1K = 5, I_W2K = 6, I_PEV = 7, I_W1V = 8, I_W2V = 9, I_WUPA = 10, I_WUPB = 11, I_WOUT = 12, I_NFFN = 13,
       I_WGRP = 14, I_BGRP = 15, I_WRT = 16, I_BRT = 17, I_WEG = 18, I_WEU = 19, I_WED = 20, I_NFIN = 21 };

__device__ __forceinline__ void build_btab(LAS unsigned char* lds, const float* rel, int hcol0, int nh, int tid) {
    LAS float* bt = (LAS float*)(lds + att::A_BT);
    if (tid < nh * 128) { const int jj = tid >> 7, d = tid & 127; bt[tid] = rel[rel_bucket(d) * 16 + hcol0 + jj] * LOG2E; }
}

__global__ void __launch_bounds__(NWAVES * 64, 2) fwd_kernel(Args args) {
    extern __shared__ __attribute__((aligned(16))) unsigned char lds_raw[];
    LAS unsigned char* lds = (LAS unsigned char*)lds_raw;
    volatile LAS unsigned* MISC = (volatile LAS unsigned*)(lds + MISC_OFF);
    const int tid = threadIdx.x, lane = tid & 63, wave = __builtin_amdgcn_readfirstlane(tid >> 6);
    const int G = gridDim.x; const int bx = blockIdx.x; const int vcu = (G % 8 == 0) ? (bx % 8) * (G / 8) + bx / 8 : bx;
    unsigned char* ws = args.ws;
    gu32* ctl = (gu32*)(ws + WS_CTL);
    for (int u = tid; u < (LDS_BYTES - LDSCTL_OFF) / 4; u += NWAVES * 64) ((LAS unsigned*)(lds + LDSCTL_OFF))[u] = 0u;
    __syncthreads();
    XcdBarrier bar = xcd_barrier_post((unsigned*)(ctl + CW_BAR), MISC + 8);
#define GRID_BAR() xcd_barrier(bar)

    const float* x = args.in[I_X]; float* out = args.out;
    bf16* WIN_T = (bf16*)(ws + WS_WIN_T); bf16* WA_T = (bf16*)(ws + WS_WA_T); bf16* WB_T = (bf16*)(ws + WS_WB_T); bf16* WO_T = (bf16*)(ws + WS_WO_T);
    bf16* W1K_T = (bf16*)(ws + WS_W1K_T); bf16* W1V_T = (bf16*)(ws + WS_W1V_T); bf16* WR_T = (bf16*)(ws + WS_WR_T); unsigned char* OA8 = ws + WS_XN; unsigned char* OB8 = ws + WS_XN + 8 * MiB;
    float* CV = (float*)(ws + WS_CV); bf16* CMPK = (bf16*)(ws + WS_CMPK); bf16* CMPV = (bf16*)(ws + WS_CMPV); bf16* OV = (bf16*)(ws + WS_OV); bf16* KM = (bf16*)(ws + WS_KM);
    bf16* XN = (bf16*)(ws + WS_XN); bf16* QA = (bf16*)(ws + WS_QA); bf16* KV6 = (bf16*)(ws + WS_KV6); bf16* QKVB = (bf16*)(ws + WS_QKVB); bf16* GM = (bf16*)(ws + WS_GM);
    float* SSQ = (float*)(ws + WS_SSQ); float* GATE = (float*)(ws + WS_GATE); float* PB = (float*)(ws + WS_P); bf16* OA = (bf16*)(ws + WS_OA); bf16* OB = (bf16*)(ws + WS_OB); bf16* MRG = (bf16*)(ws + WS_MRG);
    bf16* HB = (bf16*)(ws + WS_H); bf16* YB = (bf16*)(ws + WS_Y); int* BKT = (int*)(ws + WS_BKT); float* BKTW = (float*)(ws + WS_BKTW);
    const int gw = vcu * NWAVES + wave, NGW = G * NWAVES;

    {
        LAS float* scr = (LAS float*)(lds + RING_OFF + wave * 17408);
        constexpr int N_WIN = 32 * 156, N_W1 = 4 * 32 * 4, N_RUN = N_WIN + N_W1;
        const int l4 = 4 * (lane & 15);
        for (int it = gw; it < N_RUN; it += NGW) {
            if (it < N_WIN) { const int kb = it / 156, nb = it % 156, n = 64 * nb + l4;
                tr_item64_f8(args.in[I_WIN] + (size_t)(64 * kb) * 9752, 9752, wcol_src(n), ((nb < 16 || (nb >= 40 && nb < 56)) ? QSCALE : 1.f) * 64.f, (unsigned char*)WIN_T + (size_t)(64 * nb) * 2048 + 64 * kb, 2048, scr, lane); }
            else { const int r = it - N_WIN, mat = r >> 7, kb = (r >> 2) & 31, nb = r & 3;
                const float* src = args.in[(mat & 2) ? I_W1V : I_W1K] + (size_t)((mat & 1) * 2048 + 64 * kb) * 256;
                tr_item64(src, 256, 64 * nb + l4, 1.f, ((mat & 2) ? W1V_T : W1K_T) + (size_t)((mat & 1) * 256 + 64 * nb) * 2048 + 64 * kb, 2048, scr, lane); }
        }
        for (int m = gw; m < TOK; m += NGW) rms_row_to_fp8(x + (size_t)m * DM, args.in[I_NMIX], (unsigned char*)XN + (size_t)m * DM, lane);
        const int gt = vcu * (NWAVES * 64) + tid, NGT = G * NWAVES * 64;
        for (int i = gt; i < 256 * 128; i += NGT) { const int c = i >> 7, n = i & 127; OV[i] = (n < 64 && c < 255 && c >= 4 * n - 1 && c <= 4 * n + 3) ? (bf16)0x3f80 : (bf16)0; }
        if (gw < 128) { const int job = gw >> 2, kv = job >> 4, p = job & 15, n = (gw & 3) * 64 + lane; const float* pe = args.in[kv ? I_PEV : I_PEK] + 256 * p; const float* w1 = args.in[kv ? I_W1V : I_W1K] + (size_t)(256 * p) * 256 + n;
            float a = 0.f;
#pragma unroll 32
            for (int k = 0; k < 256; ++k) a += pe[k] * w1[(size_t)k * 256];
            CV[(kv * 16 + p) * 256 + n] = a; }
    }
    GRID_BAR();

    {
        pg8::StaticOrder S; S.init(XN, WIN_T, TOK, NPROJ, DM / 2, G, bx);
        pg8::EpiProj E{QA, KV6, QKVB, GM, GATE};
        pg8::gemm_phase<pg8::EpiProj, pg8::StaticOrder, false, false, true>(lds + RING_OFF, DM / 2, S, E);
        if (G == 256 && bx >= 224) {
            int tid_c = threadIdx.x; asm volatile("" : "+v"(tid_c)); const int lane_c = tid_c & 63, wave_c = __builtin_amdgcn_readfirstlane(tid_c >> 6);
            __syncthreads();
            LAS float* scr = (LAS float*)(lds + RING_OFF + wave_c * 17408);
            const int l4 = 4 * (lane_c & 15);
            for (int it = (bx - 224) * NWAVES + wave_c; it < 1024; it += 32 * NWAVES) { const bool second = it >= 512; const int r = it & 511, kb = r >> 5, nb = r & 31;
                tr_item64_f8(args.in[second ? I_WUPB : I_WUPA] + (size_t)(64 * kb) * 2048, 2048, 64 * nb + l4, 64.f, (unsigned char*)(second ? WB_T : WA_T) + (size_t)(64 * nb) * 1024 + 64 * kb, 1024, scr, lane_c); }
        }
    }
    GRID_BAR();

    {
        if (bx < 128) {
            pg8::SplitKOrder S{(const char*)KV6, (const char*)W1K_T, (const char*)W1V_T, bx};
            pg8::EpiF32Split E{PB};
            pg8::gemm_phase<pg8::EpiF32Split, pg8::SplitKOrder, false, false>(lds + RING_OFF, 256, S, E, 2048);
        } else {
            LAS float* red = (LAS float*)(lds + RING_OFF);
            const bf16* KBp = QKVB + 8388608u;
            for (int job = bx - 128; job < 256; job += G - 128) {
                const int bh = job >> 4, blk = job & 15, q = tid >> 7, d = tid & 127;
                const bf16* p = KBp + ((size_t)bh * 4096 + 256 * blk + 64 * q) * 128 + d; float a = 0.f;
#pragma unroll
                for (int i = 0; i < 64; ++i) a += bf2f(p[(size_t)i * 128]);
                red[tid] = a; __syncthreads();
                if (tid < 128) { const float s = (red[tid] + red[tid + 128]) + (red[tid + 256] + red[tid + 384]);
                    KM[((size_t)bh * 32 + blk) * 128 + tid] = (bf16)f2bf(s * (1.f / 256.f)); KM[((size_t)bh * 32 + 16 + blk) * 128 + tid] = (bf16)0; }
                __syncthreads();
            }
            {
                LAS float* scr = (LAS float*)(lds + RING_OFF + wave * 17408);
                const int l4 = 4 * (lane & 15), gw2 = (bx - 128) * NWAVES + wave, NGW2 = (G - 128) * NWAVES;
                for (int it = (G == 256 ? 1024 : 0) + gw2; it < 2048; it += NGW2) {
                    if (it < 1024) { const bool second = it >= 512; const int r = it & 511, kb = r >> 5, nb = r & 31;
                        tr_item64_f8(args.in[second ? I_WUPB : I_WUPA] + (size_t)(64 * kb) * 2048, 2048, 64 * nb + l4, 64.f, (unsigned char*)(second ? WB_T : WA_T) + (size_t)(64 * nb) * 1024 + 64 * kb, 1024, scr, lane); }
                    else { const int r = it - 1024, kb = r >> 5, nb = r & 31;
                        tr_item64_f8(args.in[I_WOUT] + (size_t)(64 * kb) * 2048, 2048, 64 * nb + l4, 64.f, (unsigned char*)WO_T + (size_t)(64 * nb) * 2048 + 64 * kb, 2048, scr, lane); }
                }
                const int gt = (bx - 128) * (NWAVES * 64) + tid, NGT = (G - 128) * NWAVES * 64;
                for (int i = gt; i < 80 * 2048; i += NGT) { const int n = i >> 11, k = i & 2047; float v = 0.f;
                    if (n < 8) v = args.in[I_WGRP][k * 8 + n]; else if (n < 72) v = args.in[I_WRT][(size_t)((n - 8) >> 3) * 2048 * 8 + k * 8 + ((n - 8) & 7)];
                    WR_T[((n >> 4) * 64 + (k >> 5)) * 512 + ((n & 15) + 16 * ((k & 31) >> 3)) * 8 + (k & 7)] = (bf16)f2bf(v); }
            }
        }
    }
    if (G == 256) {
        __syncthreads();
        LAS float* hid = (LAS float*)(lds + RING_OFF); LAS float* cvs = hid + 8 * 256; LAS unsigned* w2s = (LAS unsigned*)(cvs + 256);
        const int item = vcu, kv = item >> 7;
            { const GAS f32x4* w2g = (const GAS f32x4*)args.in[kv ? I_W2V : I_W2K];
              f32x4 wv[16];
#pragma unroll
              for (int i = 0; i < 16; ++i) wv[i] = w2g[tid + 512 * ((i + item) & 15)];
              __builtin_amdgcn_sched_barrier(0);
#pragma unroll
              for (int i = 0; i < 16; ++i) { const int q = tid + 512 * ((i + item) & 15); w2s[2 * q] = pk2(wv[i].x, wv[i].y); w2s[2 * q + 1] = pk2(wv[i].z, wv[i].w); } }
            if (tid < 256) { float a = 0.f;
#pragma unroll
                for (int p = 0; p < 16; ++p) a += CV[(kv * 16 + ((p + item) & 15)) * 256 + tid];
                cvs[tid] = a; }
    }
    GRID_BAR();
    {
        LAS float* hid = (LAS float*)(lds + RING_OFF);
        LAS float* cvs = hid + 8 * 256;
        LAS unsigned* w2s = (LAS unsigned*)(cvs + 256);
        for (int item = vcu; item < 256; item += G) {
            const int kv = item >> 7, R0 = (item & 127) * 8; const float* P = PB + (size_t)kv * 8 * 1024 * 512;
            if (G != 256) {
            { const GAS f32x4* w2g = (const GAS f32x4*)args.in[kv ? I_W2V : I_W2K];
              f32x4 wv[16];
#pragma unroll
              for (int i = 0; i < 16; ++i) wv[i] = w2g[tid + 512 * ((i + item) & 15)];
              __builtin_amdgcn_sched_barrier(0);
#pragma unroll
              for (int i = 0; i < 16; ++i) { const int q = tid + 512 * ((i + item) & 15); w2s[2 * q] = pk2(wv[i].x, wv[i].y); w2s[2 * q + 1] = pk2(wv[i].z, wv[i].w); } }
            if (tid < 256) { float a = 0.f;
#pragma unroll
                for (int p = 0; p < 16; ++p) a += CV[(kv * 16 + ((p + item) & 15)) * 256 + tid];
                cvs[tid] = a; }
            }
            __syncthreads();
            for (int e = tid; e < 8 * 256; e += NWAVES * 64) { const int row = e >> 8, n = e & 255, R = R0 + row; float h = 0.f;
                if ((R & 255) < 255) { float a = cvs[n];
#pragma unroll
                    for (int ks = 0; ks < 8; ++ks) a += P[(size_t)ks * 1024 * 512 + (size_t)R * 512 + n] + P[(size_t)ks * 1024 * 512 + (size_t)(R + 1) * 512 + 256 + n];
                    h = gelu_tanh(a); }
                hid[e] = h; }
            __syncthreads();
            { const int row = tid >> 6, R = R0 + row; float a0 = 0.f, a1 = 0.f;
#pragma unroll 8
              for (int k = 0; k < 256; ++k) { const float hv = hid[row * 256 + k]; const unsigned w = w2s[k * 64 + lane]; a0 += hv * bf2f(w & 0xffffu); a1 += hv * __uint_as_float(w & 0xffff0000u); }
              *(GAS unsigned*)((kv ? CMPV : CMPK) + (size_t)R * 128 + 2 * lane) = pk2(a0, a1); }
            __syncthreads();
        }
    }
    GRID_BAR();

    for (int idx = vcu; idx < 256; idx += G) {
      int tid_l = threadIdx.x; asm volatile("" : "+v"(tid_l));
      const int tid = tid_l, lane = tid & 63;
      { const int u = idx;
        const int b = u >> 7, g = (u >> 6) & 1, cur = u & 63, t0 = 64 * cur;
        const int jh = wave >> 1, wpos0 = t0 + 32 * (wave & 1), r32 = lane & 31, hi = lane >> 5, pos = wpos0 + r32, h = g * 4 + jh;
        build_btab(lds, args.in[I_REL], g * 4, 4, tid);
        __syncthreads();
        const LAS float* btab = (const LAS float*)(lds + att::A_BT) + jh * 128; const float c31 = btab[127];
        att::bf16x8 qr[8]; att::load_q(qr, QA + ((size_t)(b * 8 + h) * 4096 + wpos0) * 128);
        const bf16* Kc = CMPK + (size_t)(b * 2 + g) * 256 * 128; const bf16* Vc = CMPV + (size_t)(b * 2 + g) * 256 * 128;
        const int j_hi = ((4 * cur + 2) >> 6) + 1;
        att::f32x16 o[4]; float l;
        const float gate_cmp = GATE[(size_t)(b * 4096 + pos) * 32 + h * 3 + 0];
        att::attn_loop<att::M_CMP>(o, l, qr, Kc, Vc, 0, j_hi, pos, 0ull, wpos0, 0, btab, c31, lds);
        att::attn_prefetch(Kc, OV, 0, lds);
        att::attn_norm(o, l, gate_cmp, lds);
        att::attn_store_bf16<false>(o, OA + (size_t)(b * 4096 + wpos0) * 1024 + h * 128, 1024, lds);
        att::attn_loop<att::M_CMP, true>(o, l, qr, Kc, OV, 0, j_hi, pos, 0ull, wpos0, 0, btab, c31, lds);
        att::attn_norm(o, l, 1.f, lds);
        { LAS float* U = (LAS float*)(lds + att::A_U);
#pragma unroll
          for (int r = 0; r < 16; ++r) { const int orow = att::crow(r, hi); U[(wave * 32 + orow) * 65 + r32] = o[0][r]; U[(wave * 32 + orow) * 65 + 32 + r32] = o[1][r]; } }
        __syncthreads();
        if (wave < 2) {
            const int qi = 32 * wave + r32;
            unsigned long long mask;
            if (cur <= 15) mask = (2ull << cur) - 1ull;
            else {
                const LAS float* U = (const LAS float*)(lds + att::A_U);
                int key[31];
#pragma unroll
                for (int i = 0; i < 31; ++i) { const int n = 1 + i + 31 * hi;
                    const float sc = ((U[qi * 65 + n] + U[(64 + qi) * 65 + n]) + (U[(128 + qi) * 65 + n] + U[(192 + qi) * 65 + n])) + ((n <= cur - 2) ? 0.f : att::NEG_INF);
                    const int bts = __float_as_int(sc), mono = bts ^ ((bts >> 31) & 0x7fffffff); key[i] = (mono & ~63) | (63 - n); }
                mask = 1ull | (3ull << (cur - 1));
                for (int it = 0; it < 13; ++it) { int m = key[0];
#pragma unroll
                    for (int i = 1; i < 31; ++i) m = key[i] > m ? key[i] : m;
                    { auto rr = __builtin_amdgcn_permlane32_swap((unsigned)m, (unsigned)m, false, false); const int m0 = (int)rr[0], m1 = (int)rr[1]; m = m0 > m1 ? m0 : m1; }
                    mask |= 1ull << (63 - (m & 63));
#pragma unroll
                    for (int i = 0; i < 31; ++i) key[i] = (key[i] == m) ? (int)0x80000000 : key[i]; }
            }
            if (hi == 0) ((LAS unsigned long long*)(lds + att::A_MISC))[qi] = mask;
        }
        __syncthreads();
      }
        {
            const int bg = idx >> 6, b = bg >> 1, g = bg & 1, cur = idx & 63, t0 = 64 * cur;
            const int jh = wave >> 1, wpos0 = t0 + 32 * (wave & 1), r32 = lane & 31, pos = wpos0 + r32, h = g * 4 + jh;
            const LAS float* btab = (const LAS float*)(lds + att::A_BT) + jh * 128; const float c31 = btab[127];
            att::attn_prefetch(KV6 + 2 * 2097152u + (size_t)bg * 4096 * 128, KV6 + 3 * 2097152u + (size_t)bg * 4096 * 128, 0, lds);
            att::bf16x8 qr[8]; att::load_q(qr, QA + ((size_t)(b * 8 + h) * 4096 + wpos0) * 128);
            const unsigned long long sel = ((const LAS unsigned long long*)(lds + att::A_MISC))[pos - t0];
            const size_t kvoff = (size_t)bg * 4096 * 128;
            att::f32x16 o[4]; float l;
            const float gate_sel = GATE[(size_t)(b * 4096 + pos) * 32 + h * 3 + 1], gate_win = GATE[(size_t)(b * 4096 + pos) * 32 + h * 3 + 2];
            att::attn_loop<att::M_SEL, true>(o, l, qr, KV6 + 2 * 2097152u + kvoff, KV6 + 3 * 2097152u + kvoff, 0, cur + 1, pos, sel, wpos0, 0, btab, c31, lds);
            const int jw0 = cur > 8 ? cur - 8 : 0;
            att::attn_prefetch(KV6 + 4 * 2097152u + kvoff, KV6 + 5 * 2097152u + kvoff, jw0, lds);
            att::attn_norm(o, l, gate_sel, lds);
            att::attn_store_bf16<true>(o, OA + (size_t)(b * 4096 + wpos0) * 1024 + h * 128, 1024, lds);
            VM_WAIT();
            att::attn_loop<att::M_WIN, true>(o, l, qr, KV6 + 4 * 2097152u + kvoff, KV6 + 5 * 2097152u + kvoff, jw0, cur + 1, pos, 0ull, wpos0, 0, btab, c31, lds);
            { const int bh_m = (cur & 3) * 4 + (idx >> 6); const size_t kvm = (size_t)bh_m * 4096 * 128;
              att::attn_prefetch(QKVB + 8388608u + kvm, QKVB + 2 * 8388608u + kvm, 0, lds); }
            att::attn_norm(o, l, gate_win, lds);
            att::attn_store_f8<true>(o, OA + (size_t)(b * 4096 + wpos0) * 1024 + h * 128, 1024, OA8 + (size_t)(b * 4096 + wpos0) * 1024 + h * 128, 1024, lds);
        }
        __syncthreads();
        {
            const int cur = idx & 63, own = 15 - (cur >> 2), bh = (cur & 3) * 4 + (idx >> 6), b = bh >> 3, h = bh & 7, t0 = 256 * own;
            const int wpos0 = t0 + 32 * wave, r32 = lane & 31, hi = lane >> 5, pos = wpos0 + r32;
            build_btab(lds, args.in[I_REL], 8 + h, 1, tid);
            { LAS unsigned char* K_lds = lds + att::A_K; const int sr = tid >> 4, sc = (tid & 15) * 8;
              *(LAS att::bf16x8*)(K_lds + att::SHM_K + KSWZ(sr, sc * 2)) = *(const att::bf16x8*)(KM + ((size_t)bh * 32 + sr) * 128 + sc); }
            __syncthreads();
            const LAS float* btab = (const LAS float*)(lds + att::A_BT); const float c31 = btab[127];
            att::bf16x8 qr[8]; att::load_q(qr, QKVB + ((size_t)bh * 4096 + wpos0) * 128);
            unsigned long long sel = 0ull;
            { att::f32x16 p0, p1; att::qkt<true>(p0, p1, (const LAS char*)(lds + att::A_K + att::SHM_K), r32, hi, qr);
              float gsc[16];
#pragma unroll
              for (int q = 0; q < 4; ++q)
#pragma unroll
                  for (int i = 0; i < 4; ++i) { const float ownv = p0[(q >> 1) * 4 + i], oth = __shfl_xor(ownv, 32); gsc[4 * q + i] = (hi == (q & 1)) ? ownv : oth; }
#pragma unroll
              for (int n = 0; n < 16; ++n) if (n >= own) gsc[n] = att::NEG_INF;
              for (int it = 0; it < 3; ++it) { float best = att::NEG_INF; int bi = -1;
#pragma unroll
                  for (int n = 0; n < 16; ++n) if (gsc[n] > best) { best = gsc[n]; bi = n; }
                  if (bi >= 0) sel |= 1ull << bi;
#pragma unroll
                  for (int n = 0; n < 16; ++n) if (n == bi) gsc[n] = att::NEG_INF; } }
            __syncthreads();
            const size_t kvoff = (size_t)bh * 4096 * 128;
            att::f32x16 o[4]; float l;
            att::attn_loop<att::M_MOBA, true>(o, l, qr, QKVB + 8388608u + kvoff, QKVB + 2 * 8388608u + kvoff, 0, 4 * own + 4, pos, sel, wpos0, own, btab, c31, lds);
            att::attn_norm(o, l, 1.f, lds);
            att::attn_store_f8<false>(o, nullptr, 0, OB8 + (size_t)(b * 4096 + wpos0) * 1024 + h * 128, 1024, lds);
        }
        __syncthreads();
    }
    GRID_BAR();

    {
        int k6 = 512; asm volatile("" : "+s"(k6));
        { pg8::StaticOrder S; S.init(OA8, WA_T, TOK, DM, k6, G, bx); pg8::EpiGated<false, true> E{MRG, GM, nullptr};
          pg8::gemm_phase<pg8::EpiGated<false, true>, pg8::StaticOrder, false, false, true, 123>(lds + RING_OFF, k6, S, E); }
        { pg8::StaticOrder S; S.init(OB8, WB_T, TOK, DM, k6, G, bx); pg8::EpiGated<true, true> E{MRG, GM + 16777216u, (unsigned char*)HB};
          pg8::gemm_phase<pg8::EpiGated<true, true>, pg8::StaticOrder, false, false, true, 123>(lds + RING_OFF, k6, S, E); }
    }
    GRID_BAR();
    {
        pg8::StaticOrder S; S.init(HB, WO_T, TOK, DM, DM / 2, G, bx); pg8::EpiF32 E{out, DM, x, SSQ};
        pg8::gemm_phase<pg8::EpiF32, pg8::StaticOrder, false, false, true>(lds + RING_OFF, DM / 2, S, E);
    }
    GRID_BAR();
    {
        int tid_ = threadIdx.x; asm volatile("" : "+v"(tid_)); const int tid = tid_, lane = tid_ & 63;
        LAS float* rs = (LAS float*)(lds + RING_OFF);
        LAS float* part = rs + 64;
        LAS float* logit = part + 8 * 32 * 80;
        const bf16* WRH = WR_T;
        LAS float* rbias = logit + 32 * 80;
        if (tid < 72) rbias[tid] = tid < 8 ? args.in[I_BGRP][tid] : args.in[I_BRT][tid - 8];
        for (int it = vcu; it < TOK / 32; it += G) {
            const int m0 = 32 * it;
            if (tid < 32) { float pq[32];
#pragma unroll
                for (int q = 0; q < 32; ++q) pq[q] = SSQ[(size_t)q * 8192 + m0 + tid];
                float a = 0.f;
#pragma unroll
                for (int q = 0; q < 32; ++q) a += pq[q];
                rs[tid] = 1.f / sqrtf(a * (1.f / DM) + RMS_EPS); }
            __syncthreads();
            pg8::f32x4 acc[2][5];
#pragma unroll
            for (int a = 0; a < 2; ++a)
#pragma unroll
                for (int n = 0; n < 5; ++n) acc[a][n] = (pg8::f32x4){0.f, 0.f, 0.f, 0.f};
            const float rstd0 = rs[lane & 15], rstd1 = rs[16 + (lane & 15)];
#pragma unroll 4
            for (int ks = 0; ks < 8; ++ks) { const int k0 = 256 * wave + 32 * ((ks + (it & 7)) & 7) + 8 * (lane >> 4);
                const f32x4 g0 = *(const GAS f32x4*)(args.in[I_NFFN] + k0), g1 = *(const GAS f32x4*)(args.in[I_NFFN] + k0 + 4);
                bf16x8 ahi[2], alo[2];
#pragma unroll
                for (int a = 0; a < 2; ++a) { const size_t tok = (size_t)(m0 + 16 * a + (lane & 15)); const float rstd = a ? rstd1 : rstd0;
                    f32x4 a0 = *(const GAS f32x4*)(out + tok * DM + k0), a1 = *(const GAS f32x4*)(out + tok * DM + k0 + 4);
                    a0.x *= rstd * g0.x; a0.y *= rstd * g0.y; a0.z *= rstd * g0.z; a0.w *= rstd * g0.w; a1.x *= rstd * g1.x; a1.y *= rstd * g1.y; a1.z *= rstd * g1.z; a1.w *= rstd * g1.w;
                    v4u hi4, lo4;
                    { const unsigned h0 = f2bf(a0.x), h1 = f2bf(a0.y), h2 = f2bf(a0.z), h3 = f2bf(a0.w), h4 = f2bf(a1.x), h5 = f2bf(a1.y), h6 = f2bf(a1.z), h7 = f2bf(a1.w);
                      hi4.x = h0 | (h1 << 16); hi4.y = h2 | (h3 << 16); hi4.z = h4 | (h5 << 16); hi4.w = h6 | (h7 << 16);
                      lo4.x = pk2(a0.x - bf2f(h0), a0.y - bf2f(h1)); lo4.y = pk2(a0.z - bf2f(h2), a0.w - bf2f(h3)); lo4.z = pk2(a1.x - bf2f(h4), a1.y - bf2f(h5)); lo4.w = pk2(a1.z - bf2f(h6), a1.w - bf2f(h7)); }
                    *(GAS v4u*)(XN + tok * DM + k0) = hi4;
                    ahi[a] = __builtin_bit_cast(bf16x8, hi4); alo[a] = __builtin_bit_cast(bf16x8, lo4); }
#pragma unroll
                for (int n = 0; n < 5; ++n) { const size_t wo = (size_t)((n * 64 + (k0 >> 5)) * 512 + lane * 8);
                    const bf16x8 bh = *(const bf16x8*)(WRH + wo);
#pragma unroll
                    for (int a = 0; a < 2; ++a) {
                        acc[a][n] = __builtin_amdgcn_mfma_f32_16x16x32_bf16(ahi[a], bh, acc[a][n], 0, 0, 0);
                        acc[a][n] = __builtin_amdgcn_mfma_f32_16x16x32_bf16(alo[a], bh, acc[a][n], 0, 0, 0); } } }
#pragma unroll
            for (int a = 0; a < 2; ++a)
#pragma unroll
                for (int n = 0; n < 5; ++n)
#pragma unroll
                    for (int i = 0; i < 4; ++i) part[(wave * 32 + 16 * a + 4 * (lane >> 4) + i) * 80 + 16 * n + (lane & 15)] = acc[a][n][i];
            __syncthreads();
            for (int e = tid; e < 32 * 80; e += NWAVES * 64) { float a = 0.f;
#pragma unroll
                for (int w = 0; w < 8; ++w) a += part[w * 32 * 80 + e];
                logit[e] = a; }
            __syncthreads();
            if (tid < 32) { const LAS float* lg = logit + tid * 80; const LAS float* bg = rbias; const LAS float* br = rbias + 8;
                float gmax = att::NEG_INF; int gi = 0;
#pragma unroll
                for (int n = 0; n < 8; ++n) { const float v = lg[n] + bg[n]; if (v > gmax) { gmax = v; gi = n; } }
                float gsum = 0.f;
#pragma unroll
                for (int n = 0; n < 8; ++n) gsum += __expf(lg[n] + bg[n] - gmax);
                const float gval = 1.f / gsum;
                float e0 = att::NEG_INF, e1 = att::NEG_INF; int i0 = 0, i1 = 0;
#pragma unroll
                for (int j = 0; j < 8; ++j) { const float v = lg[8 + gi * 8 + j] + br[gi * 8 + j];
                    if (v > e0) { e1 = e0; i1 = i0; e0 = v; i0 = j; } else if (v > e1) { e1 = v; i1 = j; } }
                const float p1 = __expf(e1 - e0), den = 1.f / (1.f + p1);
                const float w0 = gval * den, w1 = gval * p1 * den;
                const int tok = m0 + tid, ex0 = gi * 8 + i0, ex1 = gi * 8 + i1;
                const unsigned q0 = __hip_atomic_fetch_add((unsigned*)(ctl + CW_CNT + ex0), 1u, RLX_AGENT);
                const unsigned q1 = __hip_atomic_fetch_add((unsigned*)(ctl + CW_CNT + ex1), 1u, RLX_AGENT);
                BKT[ex0 * 8192 + q0] = tok; BKTW[ex0 * 8192 + q0] = w0;
                BKT[ex1 * 8192 + q1] = tok | (1 << 16); BKTW[ex1 * 8192 + q1] = w1; }
            __syncthreads();
        }
    }
    GRID_BAR();
    {
        LAS pg8::MoeTile* tiles = (LAS pg8::MoeTile*)(lds + TILES_OFF);
        int tid_t = threadIdx.x; asm volatile("" : "+v"(tid_t));
        if (tid_t < 64) {
            const int e = tid_t; const int c = (int)__hip_atomic_load((unsigned*)(ctl + CW_CNT + e), RLX_AGENT); const int ntl = (c + mg::TM - 1) / mg::TM;
            int pc = c, pt = ntl;
#pragma unroll
            for (int o = 1; o < 64; o <<= 1) { const int a = __shfl_up(pc, o), b = __shfl_up(pt, o); if (e >= o) { pc += a; pt += b; } }
            const int rowbase = pc - c, t0 = pt - ntl;
            for (int mt = 0; mt < ntl; ++mt) if (t0 + mt < 128) { tiles[t0 + mt].e = e; tiles[t0 + mt].mt = mt; tiles[t0 + mt].cnt = c; tiles[t0 + mt].rowbase = rowbase; }
            if (e == 63) MISC[16] = (unsigned)(pt < 128 ? pt : 128); }
        __syncthreads();
        const int ntiles = (int)MISC[16];
        { mg::MoePhase P{(const MLAS mg::MoeTileL*)tiles, ntiles, (const char*)XN, args.in[I_WEG], args.in[I_WEU], BKT, BKTW, HB, YB};
          mg::moe_phase<0>(lds + RING_OFF, P, vcu, G); }
        GRID_BAR();
        { mg::MoePhase P{(const MLAS mg::MoeTileL*)tiles, ntiles, (const char*)HB, args.in[I_WED], nullptr, BKT, BKTW, HB, YB};
          mg::moe_phase<1>(lds + RING_OFF, P, vcu, G); }
    }
    GRID_BAR();
    {
        int tid_ = threadIdx.x; asm volatile("" : "+v"(tid_)); const int lane = tid_ & 63;
        const float* gain = args.in[I_NFIN];
        const bool poison = (__hip_atomic_load(ctl + CW_BAR + XB_TMO, RLX_AGENT) != 0u) || (__hip_atomic_load(ctl + CW_TMO, RLX_AGENT) != 0u);
        f32x4 gv[8];
#pragma unroll
        for (int p = 0; p < 4; ++p) { gv[2 * p] = *(const GAS f32x4*)(gain + 512 * p + 8 * lane); gv[2 * p + 1] = *(const GAS f32x4*)(gain + 512 * p + 8 * lane + 4); }
        f32x4 xv[8]; v4u y0v[4], y1v[4];
        const float* xbase = out;
#define P11_LOAD(m_) do { _Pragma("unroll") for (int p = 0; p < 4; ++p) { const int c0 = 512 * p + 8 * lane; \
            xv[2 * p] = *(const GAS f32x4*)(xbase + (size_t)(m_) * DM + c0); xv[2 * p + 1] = *(const GAS f32x4*)(xbase + (size_t)(m_) * DM + c0 + 4); \
            y0v[p] = *(const GAS v4u*)(YB + (size_t)(m_) * DM + c0); y1v[p] = *(const GAS v4u*)(YB + (size_t)(TOK + (m_)) * DM + c0); } } while (0)
        if (gw < TOK) P11_LOAD(gw);
        for (int m = gw; m < TOK; m += NGW) {
            f32x4 v[8]; float s = 0.f;
#pragma unroll
            for (int p = 0; p < 4; ++p) { v[2 * p] = xv[2 * p]; v[2 * p + 1] = xv[2 * p + 1];
                const v4u y0 = y0v[p], y1 = y1v[p];
                v[2 * p].x += bf2f(y0.x & 0xffffu) + bf2f(y1.x & 0xffffu); v[2 * p].y += bf2f(y0.x >> 16) + bf2f(y1.x >> 16); v[2 * p].z += bf2f(y0.y & 0xffffu) + bf2f(y1.y & 0xffffu); v[2 * p].w += bf2f(y0.y >> 16) + bf2f(y1.y >> 16);
                v[2 * p + 1].x += bf2f(y0.z & 0xffffu) + bf2f(y1.z & 0xffffu); v[2 * p + 1].y += bf2f(y0.z >> 16) + bf2f(y1.z >> 16); v[2 * p + 1].z += bf2f(y0.w & 0xffffu) + bf2f(y1.w & 0xffffu); v[2 * p + 1].w += bf2f(y0.w >> 16) + bf2f(y1.w >> 16);
            }
            if (m + NGW < TOK) P11_LOAD(m + NGW);
#pragma unroll
            for (int j = 0; j < 8; ++j) s += (v[j].x * v[j].x + v[j].y * v[j].y) + (v[j].z * v[j].z + v[j].w * v[j].w);
            const float rstd = 1.f / sqrtf(wave_sum(s) * (1.f / DM) + RMS_EPS);
#pragma unroll
            for (int p = 0; p < 4; ++p) { const int c0 = 512 * p + 8 * lane;
#pragma unroll
                for (int q = 0; q < 2; ++q) { const f32x4 g = gv[2 * p + q]; const f32x4 w = v[2 * p + q]; f32x4 y; y.x = w.x * rstd * g.x; y.y = w.y * rstd * g.y; y.z = w.z * rstd * g.z; y.w = w.w * rstd * g.w;
                    if (poison) { const float qn = __builtin_nanf(""); y.x = qn; y.y = qn; y.z = qn; y.w = qn; }
                    *(GAS f32x4*)(out + (size_t)m * DM + c0 + 4 * q) = y; } }
        }
#undef P11_LOAD
    }
#undef GRID_BAR
}

extern "C" void kernel_launch(void* const* d_in, const int* in_sizes, int n_in, void* d_out, int out_size, void* d_ws, size_t ws_size, hipStream_t stream) {
    static int grid = 0;
    if (grid == 0) {
        if (n_in != 22 || in_sizes[0] != TOK * DM || out_size != TOK * DM || ws_size < WS_END) {
            fprintf(stderr, "kernel_launch: unexpected problem (n_in %d, in0 %d, out %d, ws %zu < %zu?); nothing launched\n", n_in, n_in > 0 ? in_sizes[0] : -1, out_size, ws_size, (size_t)WS_END); grid = -1; return; }
        int dev = 0, cus = 0, per_cu = 0;
        if (hipGetDevice(&dev) != hipSuccess || hipDeviceGetAttribute(&cus, hipDeviceAttributeMultiprocessorCount, dev) != hipSuccess) { fprintf(stderr, "kernel_launch: device query failed\n"); grid = -1; return; }
        if (hipFuncSetAttribute((const void*)fwd_kernel, hipFuncAttributeMaxDynamicSharedMemorySize, LDS_BYTES) != hipSuccess) { fprintf(stderr, "kernel_launch: hipFuncSetAttribute failed\n"); grid = -1; return; }
        if (hipOccupancyMaxActiveBlocksPerMultiprocessor(&per_cu, (const void*)fwd_kernel, NWAVES * 64, LDS_BYTES) != hipSuccess || per_cu < 1)
            fprintf(stderr, "kernel_launch: note: occupancy query reports %d workgroups per CU\n", per_cu);
        (void)hipGetLastError();
        grid = cus;
    }
    if (grid < 0) return;
    if (hipMemsetAsync((char*)d_ws + WS_CTL, 0, CTL_ZERO_BYTES, stream) != hipSuccess) { fprintf(stderr, "kernel_launch: memset failed\n"); return; }
    Args a{};
    for (int i = 0; i < 22; ++i) a.in[i] = (const float*)d_in[i];
    a.out = (float*)d_out; a.ws = (unsigned char*)d_ws;
    hipLaunchKernelGGL(fwd_kernel, dim3(grid), dim3(NWAVES * 64), LDS_BYTES, stream, a);
    const hipError_t le = hipPeekAtLastError();
    if (le != hipSuccess) fprintf(stderr, "kernel_launch: launch failed: %s\n", hipGetErrorName(le));
}
```
